# Optimizing an MI355X kernel written in HIP

```python
import math
import jax, jax.numpy as jnp
from jax import lax
import numpy as np

D_MODEL = 2048
BATCH = 4
SEQ = 4096
DEPTH = 4

N_META = 16
CHUNK = 128
PAD_FRONT = CHUNK - N_META
A_HEADS = D_MODEL // 256
A_QK_DIM = 64
A_V_DIM = 128
D_A = A_HEADS * A_V_DIM
R_HEADS = D_MODEL // 512
R_QK_DIM = 128
R_V_DIM = 256
D_R = R_HEADS * R_V_DIM
D_MIX = D_A + D_R
COL_SIZES = (A_HEADS * 2 * A_QK_DIM, A_HEADS * 2 * A_QK_DIM, D_A,
             R_HEADS * R_QK_DIM, R_HEADS * R_QK_DIM, D_R, D_R)
SPLITS = tuple(int(s) for s in np.cumsum(COL_SIZES)[:-1])
D_IN = int(sum(COL_SIZES))
D_FF = 256 * math.ceil(8 * D_MODEL / 3 / 256)
CONV_W = 3
EPS = 1e-6
NEG_INF = -1e30

kernel_name = "hymba_diffattn_retnet_convffn"


def rmsnorm(x, g):
    xf = x.astype(jnp.float32)
    y = xf * lax.rsqrt(jnp.mean(xf * xf, axis=-1, keepdims=True) + EPS)
    return (y * g.astype(jnp.float32)).astype(x.dtype)


def diff_attention(q, k, v, lam, slopes, valid):
    B, L, H, _, dqk = q.shape
    dv = v.shape[-1]
    scale = dqk ** -0.5
    kpos = jnp.arange(L)

    def block(start):
        qb = lax.dynamic_slice_in_dim(q, start, CHUNK, axis=1)
        s = jnp.einsum('bqhmd,bkhmd->bhmqk', qb, k).astype(jnp.float32) * scale
        qpos = start + jnp.arange(CHUNK)
        dist = (qpos[:, None] - kpos[None, :])
        bias = -slopes[:, None, None] * dist.astype(jnp.float32)
        mask = (dist >= 0) & valid[None, :]
        s = jnp.where(mask[None, None, None], s + bias[None, :, None], NEG_INF)
        p = jax.nn.softmax(s, axis=-1)
        a = (p[:, :, 0] - lam * p[:, :, 1]).astype(v.dtype)
        return jnp.einsum('bhqk,bkhe->bqhe', a, v)

    starts = jnp.arange(L // CHUNK) * CHUNK
    out = lax.map(block, starts)
    return jnp.transpose(out, (1, 0, 2, 3, 4)).reshape(B, L, H, dv)


def retention(q, k, v, log_g):
    B, L, H, dk = q.shape
    dv = v.shape[-1]
    N = L // CHUNK
    dt = q.dtype
    q = q.reshape(B, N, CHUNK, H, dk)
    k = k.reshape(B, N, CHUNK, H, dk) * (dk ** -0.5)
    v = v.reshape(B, N, CHUNK, H, dv)
    idx = jnp.arange(CHUNK, dtype=jnp.float32)
    diff = idx[:, None] - idx[None, :]
    decay_in = jnp.where(diff >= 0, jnp.exp(log_g[:, None, None] * jnp.maximum(diff, 0.0)), 0.0)
    s = jnp.einsum('bnihd,bnjhd->bnhij', q, k) * decay_in.astype(dt)[None, None]
    intra = jnp.einsum('bnhij,bnjhe->bnihe', s, v)
    k_dec = k * jnp.exp(log_g[None, :] * (CHUNK - 1 - idx)[:, None]).astype(dt)[None, None, :, :, None]
    kv = jnp.einsum('bnjhd,bnjhe->nbhde', k_dec, v)
    g_chunk = jnp.exp(log_g * CHUNK).astype(kv.dtype)[None, :, None, None]

    def step(S, kv_n):
        return g_chunk * S + kv_n, S

    _, S_prev = lax.scan(step, jnp.zeros((B, H, dk, dv), kv.dtype), kv)
    q_dec = q * jnp.exp(log_g[None, :] * (idx + 1.0)[:, None]).astype(dt)[None, None, :, :, None]
    cross = jnp.einsum('bnihd,nbhde->bnihe', q_dec, S_prev)
    return (intra + cross).reshape(B, L, H, dv)


def conv_glu(u, w_gate, w_up, conv_w, w_down):
    L = u.shape[1]
    g = u @ w_gate
    gp = jnp.pad(g, ((0, 0), (CONV_W - 1, 0), (0, 0)))
    gc = gp[:, 0:L] * conv_w[0]
    for i in range(1, CONV_W):
        gc = gc + gp[:, i:i + L] * conv_w[i]
    return (jax.nn.silu(gc) * (u @ w_up)) @ w_down


def setup_inputs(seed: int = 0) -> dict:
    key = jax.random.key(seed)
    ks = jax.random.split(key, 14)
    f32 = jnp.float32
    nrm = lambda k, shape, s: jax.random.normal(k, shape, f32) * s
    return {
        "x": nrm(ks[0], (BATCH, SEQ, D_MODEL), 1.0),
        "meta_tokens": nrm(ks[1], (N_META, D_MODEL), 1.0),
        "attn_norm": 1.0 + nrm(ks[2], (DEPTH, D_MODEL), 0.02),
        "w_in": nrm(ks[3], (DEPTH, D_MODEL, D_IN), D_MODEL ** -0.5),
        "lambda_qk": nrm(ks[4], (DEPTH, 4, A_QK_DIM), 0.1),
        "attn_subln": 1.0 + nrm(ks[5], (DEPTH, A_V_DIM), 0.02),
        "ret_norm": 1.0 + nrm(ks[6], (DEPTH, R_V_DIM), 0.02),
        "w_out": nrm(ks[7], (DEPTH, D_MIX, D_MODEL), D_MIX ** -0.5),
        "ffn_norm": 1.0 + nrm(ks[8], (DEPTH, D_MODEL), 0.02),
        "w_gate": nrm(ks[9], (DEPTH, D_MODEL, D_FF), D_MODEL ** -0.5),
        "w_up": nrm(ks[10], (DEPTH, D_MODEL, D_FF), D_MODEL ** -0.5),
        "conv_w": nrm(ks[11], (DEPTH, CONV_W, D_FF), CONV_W ** -0.5),
        "w_down": nrm(ks[12], (DEPTH, D_FF, D_MODEL), D_FF ** -0.5),
        "final_norm": 1.0 + nrm(ks[13], (D_MODEL,), 0.02),
    }


def reference(x, meta_tokens, attn_norm, w_in, lambda_qk, attn_subln, ret_norm, w_out,
              ffn_norm, w_gate, w_up, conv_w, w_down, final_norm):
    B, S, D = x.shape
    L = CHUNK + S
    pad = jnp.zeros((B, PAD_FRONT, D), x.dtype)
    meta = jnp.broadcast_to(meta_tokens.astype(x.dtype)[None], (B, N_META, D))
    h = jnp.concatenate([pad, meta, x], axis=1)
    valid = jnp.arange(L) >= PAD_FRONT
    vmask = valid.astype(x.dtype)[None, :, None]
    slopes = 2.0 ** (-8.0 * jnp.arange(1, A_HEADS + 1, dtype=jnp.float32) / A_HEADS)
    log_g = jnp.log1p(-(2.0 ** (-5.0 - jnp.arange(R_HEADS, dtype=jnp.float32))))

    for l in range(DEPTH):
        lam_init = 0.8 - 0.6 * math.exp(-0.3 * l)
        u = rmsnorm(h, attn_norm[l]) * vmask
        proj = u @ w_in[l]
        aq, ak, av, rq, rk, rv, rg = jnp.split(proj, SPLITS, axis=-1)
        lq = lambda_qk[l].astype(jnp.float32)
        lam = jnp.exp(jnp.sum(lq[0] * lq[1])) - jnp.exp(jnp.sum(lq[2] * lq[3])) + lam_init
        ya = diff_attention(aq.reshape(B, L, A_HEADS, 2, A_QK_DIM),
                            ak.reshape(B, L, A_HEADS, 2, A_QK_DIM),
                            av.reshape(B, L, A_HEADS, A_V_DIM), lam, slopes, valid)
        ya = rmsnorm(ya, attn_subln[l]) * (1.0 - lam_init)
        yr = retention(rq.reshape(B, L, R_HEADS, R_QK_DIM),
                       rk.reshape(B, L, R_HEADS, R_QK_DIM),
                       rv.reshape(B, L, R_HEADS, R_V_DIM), log_g)
        yr = rmsnorm(yr, ret_norm[l]) * jax.nn.silu(rg.reshape(B, L, R_HEADS, R_V_DIM))
        y = jnp.concatenate([ya.reshape(B, L, D_A), yr.reshape(B, L, D_R)], axis=-1)
        h = h + y @ w_out[l]
        u = rmsnorm(h, ffn_norm[l]) * vmask
        h = h + conv_glu(u, w_gate[l], w_up[l], conv_w[l], w_down[l])

    out = rmsnorm(h, final_norm)
    return out[:, CHUNK:]
```

```cpp
#include <hip/hip_runtime.h>
#include <hip/hip_cooperative_groups.h>
#include <cstdio>
#include <cstdint>
namespace cg = cooperative_groups;

#define LAS __attribute__((address_space(3)))
typedef unsigned short bf16_t;
typedef short bf16x8 __attribute__((ext_vector_type(8)));
typedef short s16x4 __attribute__((ext_vector_type(4)));
typedef float f32x4 __attribute__((ext_vector_type(4)));
typedef float f32x2 __attribute__((ext_vector_type(2)));
typedef float f32x16 __attribute__((ext_vector_type(16)));
typedef unsigned u32x4 __attribute__((ext_vector_type(4)));
typedef unsigned u32x2 __attribute__((ext_vector_type(2)));

constexpr int DM = 2048, NB = 4, SEQ = 4096, DEPTH = 4, LTOK = 4224, PADF = 112, CH = 128, NCH = 33;
constexpr int MT = NB * LTOK;
constexpr int DIN = 6144, DFF = 5632;
constexpr int C_AQ = 0, C_AK = 1024, C_AV = 2048, C_RQ = 3072, C_RK = 3584, C_RV = 4096, C_RG = 5120;
constexpr float EPS = 1e-6f;
constexpr float LOG2E = 1.4426950408889634f;

constexpr size_t WS_CTL = 0, CTL_BYTES = 1u << 20;
constexpr size_t CTL_SSQ_OFF = 4096;
constexpr size_t WT_IN = 0, WT_OUT = 25165824, WT_GATE = 33554432, WT_UP = 56623104, WT_DOWN = 79691776, WT_LAYER = 102760448;
constexpr size_t WS_WT = CTL_BYTES;
constexpr size_t WS_H = WS_WT + 4 * WT_LAYER;
constexpr size_t WS_R = WS_H + (size_t)MT * DM * 4;
constexpr size_t R_PROJ = 0, R_Y = (size_t)MT * DIN * 2, R_KV = R_Y + (size_t)MT * DM * 2;
constexpr size_t R_G = 0, R_ACT = (size_t)MT * DFF * 2;
constexpr size_t WS_SSQ = WS_R + 2 * (size_t)MT * DFF * 2;
constexpr size_t WS_END = WS_SSQ + 2 * (size_t)MT * 32 * 4;
constexpr size_t OUT_HB = 0, OUT_SPREV = (size_t)MT * DM * 2;

constexpr int REP_PRO = 1, REP_INP = 1, REP_MIX = 1, REP_GATE = 1, REP_UP = 1, REP_KV = 1, XREP_ATT = 0, XREP_RET = 0, XSYNC = 0, XREP_OUT = 0, XREP_DOWN = 0;
constexpr int CV_IN = 32 * 192, CV_OUT = CV_IN + 32 * 64, CV_GATE = CV_OUT + 32 * 176, CV_UP = CV_GATE + 32 * 176, CV_ALL = CV_UP + 88 * 64;
constexpr int LDS_BYTES = 147456;
constexpr int LDS_MISC = 144384;

__device__ __forceinline__ unsigned cvt_pk_bf16(float lo, float hi) { unsigned r; asm volatile("v_cvt_pk_bf16_f32 %0, %1, %2" : "=v"(r) : "v"(lo), "v"(hi)); return r; }
__device__ __forceinline__ float bf_lo(unsigned w) { return __uint_as_float(w << 16); }
__device__ __forceinline__ float bf_hi(unsigned w) { return __uint_as_float(w & 0xffff0000u); }
__device__ __forceinline__ bool is_pad_row(int row) { return (row % LTOK) < PADF; }
__device__ __forceinline__ float row_rstd(const float* part, int row) {
    const f32x4* p = (const f32x4*)(part + (size_t)row * 32);
    float s = 0.f;
#pragma unroll
    for (int k = 0; k < 8; ++k) { const f32x4 v = p[k]; s += (v[0] + v[1]) + (v[2] + v[3]); }
    return __builtin_amdgcn_rsqf(s * (1.0f / 2048.0f) + 1e-6f);
}
__device__ __forceinline__ float wave_sum(float v) {
#pragma unroll
    for (int o = 1; o < 64; o <<= 1) v += __shfl_xor(v, o);
    return v;
}

namespace pg8 {
#define PG8_LAS __attribute__((address_space(3)))
constexpr int BM = 256, BK = 64, HALF = 128, HTB = HALF * BK * 2, STAGE_BYTES = 8 * HTB, NXCD = 8, WGM = 8;
__host__ __device__ __forceinline__ int lds_byte(int r, int c) { const int st = (r >> 4) * 2 + (c >> 5), rr = r & 15, cc = c & 31, ob = rr * 64 + cc * 2; return st * 1024 + (ob ^ (((ob >> 9) & 1) << 5)); }
__host__ __device__ __forceinline__ void stage_rc(int b, int& R, int& C) { const int st = b / 1024, sb = b % 1024, swz = sb ^ (((sb >> 9) & 1) << 5); R = (st >> 1) * 16 + swz / 64; C = (st & 1) * 32 + (swz % 64) / 2; }
__host__ __device__ __forceinline__ int perm32(int rho) { const int n = rho >> 4, i = rho & 15; return 8 * (i >> 2) + 4 * n + (i & 3); }
struct Unit { int pm, pn, ks; };
struct Gemm { const bf16_t* A; const bf16_t* Bt; int M, N, K, ld; };
__host__ __device__ __forceinline__ void tile_of(int wgid, int nM, int nN, int& pm, int& pn) {
    const int nwg = nM * nN;
    { const int q = nwg / NXCD, r = nwg % NXCD, xcd = wgid % NXCD, off = wgid / NXCD; wgid = (xcd < r ? xcd * (q + 1) : r * (q + 1) + (xcd - r) * q) + off; }
    const int nig = WGM * nN, gid = wgid / nig, fm = gid * WGM, gsz = (nM - fm) < WGM ? (nM - fm) : WGM;
    pm = fm + ((wgid % nig) % gsz); pn = (wgid % nig) / gsz;
}
struct StaticOrder {
    int nM, nN, nwg, G, c, limit;
    __host__ __device__ void init(int M, int N, int G_, int c_) { nM = M / BM; nN = N / BM; nwg = nM * nN; G = G_; c = c_; limit = nwg; }
    __host__ __device__ bool next(int i, Unit& u) const {
        const long L = (long)i * G + c; if (L >= limit) return false;
        tile_of((int)L, nM, nN, u.pm, u.pn); u.ks = 0; return true;
    }
    __device__ __forceinline__ void a_ready(const Unit&) const {}
    __device__ __forceinline__ void done(const Unit&) const {}
};
struct TailOrder {
    int nM, nN, first, ntiles, c;
    __host__ __device__ bool next(int i, Unit& u) const {
        if (i != 0 || c >= 4 * ntiles) return false;
        tile_of(first + (c >> 2), nM, nN, u.pm, u.pn); u.ks = c & 3; return true;
    }
    __device__ __forceinline__ void a_ready(const Unit&) const {}
    __device__ __forceinline__ void done(const Unit&) const {}
};

__device__ __forceinline__ void rstd_table(PG8_LAS unsigned char* lds, const float* part, int pm, int tid) {
    PG8_LAS float* RS = (PG8_LAS float*)(lds + 131072);
    const int rl = tid >> 1, row = pm * BM + rl;
    const f32x4* p = (const f32x4*)(part + (size_t)row * 32 + (tid & 1) * 16);
    const f32x4 v0 = p[0], v1 = p[1], v2 = p[2], v3 = p[3];
    float s = (((v0[0] + v0[1]) + (v0[2] + v0[3])) + ((v1[0] + v1[1]) + (v1[2] + v1[3]))) + (((v2[0] + v2[1]) + (v2[2] + v2[3])) + ((v3[0] + v3[1]) + (v3[2] + v3[3])));
    const float o = __shfl_xor(s, 1);
    s = (tid & 1) ? o + s : s + o;
    if ((tid & 1) == 0) RS[rl] = is_pad_row(row) ? 0.f : __builtin_amdgcn_rsqf(s * (1.0f / 2048.0f) + 1e-6f);
    asm volatile("s_waitcnt lgkmcnt(0)" ::: "memory"); __builtin_amdgcn_s_barrier(); asm volatile("" ::: "memory");
}
struct EpiScaleBf16 {
    static constexpr bool PERM = true, AFTER_DRAIN = false, OVERLAP = false;
    bf16_t* O; int ldc; const float* ssq;
    __device__ __forceinline__ void operator()(const f32x4 (&acc)[2][2][4][2], const Unit& u, int wr, int wc, int fr, int fq, PG8_LAS unsigned char* lds, int tid, int quad = -1) const {
        rstd_table(lds, ssq, u.pm, tid);
        const PG8_LAS float* RS = (const PG8_LAS float*)(lds + 131072);
        const int rl0 = wr * 64 + fr; const int col0 = u.pn * BM + wc * 32 + 8 * fq;
#pragma unroll
        for (int ai = 0; ai < 2; ++ai)
#pragma unroll
            for (int m = 0; m < 4; ++m) {
                if (quad >= 0 && ai * 2 + (m >> 1) != quad) continue;
                const int rl = rl0 + ai * HALF + m * 16;
                const float sc = RS[rl];
                bf16_t* rowp = O + (size_t)(u.pm * BM + rl) * ldc + col0;
#pragma unroll
                for (int bj = 0; bj < 2; ++bj) { const f32x4 v0 = acc[ai][bj][m][0] * sc, v1 = acc[ai][bj][m][1] * sc;
                    u32x4 w; w.x = cvt_pk_bf16(v0[0], v0[1]); w.y = cvt_pk_bf16(v0[2], v0[3]); w.z = cvt_pk_bf16(v1[0], v1[1]); w.w = cvt_pk_bf16(v1[2], v1[3]);
                    *(u32x4*)(rowp + bj * HALF) = w; }
            }
    }
};
template <bool FIRST> struct EpiResidual {
    static constexpr bool PERM = true, AFTER_DRAIN = false, OVERLAP = false;
    bf16_t* hlo; bf16_t* hb; float* ssq_next; float scale;
    __device__ __forceinline__ void operator()(const f32x4 (&acc)[2][2][4][2], const Unit& u, int wr, int wc, int fr, int fq, PG8_LAS unsigned char* lds, int tid, int quad = -1) const {
        const int row0 = u.pm * BM + wr * 64 + fr; const int col0 = u.pn * BM + wc * 32 + 8 * fq;
        const int b0_ = row0 / LTOK, t0_ = row0 % LTOK; (void)b0_; (void)t0_;
        const float* x0 = nullptr; const float* meta0 = nullptr;
        if constexpr (FIRST) { x0 = (const float*)(*(const PG8_LAS unsigned long long*)(lds + 144384 + 64)); meta0 = (const float*)(*(const PG8_LAS unsigned long long*)(lds + 144384 + 72)); }
        f32x4 pre[2][2][2];
#define E2_LOAD(p, buf) do { const int row_ = row0 + ((p) >> 2) * HALF + ((p) & 3) * 16; \
            if constexpr (FIRST) { int t_ = t0_ + ((p) >> 2) * HALF + ((p) & 3) * 16, bb_ = b0_; if (t_ >= LTOK) { t_ -= LTOK; bb_ += 1; } \
                const float* src_ = t_ < CH ? meta0 + (size_t)(t_ < PADF ? 0 : t_ - PADF) * DM : x0 + ((size_t)bb_ * SEQ + (t_ - CH)) * DM; \
                _Pragma("unroll") for (int bj_ = 0; bj_ < 2; ++bj_) _Pragma("unroll") for (int n_ = 0; n_ < 2; ++n_) pre[buf][bj_][n_] = *(const f32x4*)(src_ + col0 + bj_ * HALF + n_ * 4); } \
            else { _Pragma("unroll") for (int bj_ = 0; bj_ < 2; ++bj_) { const size_t off_ = (size_t)row_ * DM + col0 + bj_ * HALF; \
                pre[buf][bj_][0] = __builtin_bit_cast(f32x4, *(const u32x4*)(hb + off_)); } } } while (0)
        if (quad < 0) E2_LOAD(0, 0);
#pragma unroll
        for (int p = 0; p < 8; ++p) {
            if (quad >= 0) { if ((p >> 1) != quad) continue; E2_LOAD(p, p & 1); }
            else if (p + 1 < 8) E2_LOAD(p + 1, (p + 1) & 1);
            asm volatile("" ::: "memory");
            const int ai = p >> 2, m = p & 3;
            {
                const int row = row0 + ai * HALF + m * 16; const bool pad = is_pad_row(row);
                float ss = 0.f;
#pragma unroll
                for (int bj = 0; bj < 2; ++bj) {
                    const size_t off = (size_t)row * DM + col0 + bj * HALF;
                    f32x4 r0, r1;
                    if constexpr (FIRST) { r0 = pre[p & 1][bj][0]; r1 = pre[p & 1][bj][1]; }
                    else { const u32x4 hi = __builtin_bit_cast(u32x4, pre[p & 1][bj][0]);
                        r0 = (f32x4){bf_lo(hi[0]), bf_hi(hi[0]), bf_lo(hi[1]), bf_hi(hi[1])};
                        r1 = (f32x4){bf_lo(hi[2]), bf_hi(hi[2]), bf_lo(hi[3]), bf_hi(hi[3])}; }
                    f32x4 v0 = r0 + acc[ai][bj][m][0] * scale, v1 = r1 + acc[ai][bj][m][1] * scale;
                    if (pad) { v0 = (f32x4){0.f, 0.f, 0.f, 0.f}; v1 = v0; }
                    u32x4 w; w.x = cvt_pk_bf16(v0[0], v0[1]); w.y = cvt_pk_bf16(v0[2], v0[3]); w.z = cvt_pk_bf16(v1[0], v1[1]); w.w = cvt_pk_bf16(v1[2], v1[3]);
                    *(u32x4*)(hb + off) = w;
                    ss += ((v0[0] * v0[0] + v0[1] * v0[1]) + (v0[2] * v0[2] + v0[3] * v0[3])) + ((v1[0] * v1[0] + v1[1] * v1[1]) + (v1[2] * v1[2] + v1[3] * v1[3]));
                }
                ss += __shfl_xor(ss, 16); ss += __shfl_xor(ss, 32);
                if (fq == 0) ssq_next[(size_t)row * 32 + u.pn * 4 + wc] = ss;
            }
            asm volatile("" ::: "memory");
        }
#undef E2_LOAD
    }
};
struct EpiUpConv {
    static constexpr bool PERM = true, AFTER_DRAIN = false, OVERLAP = false;
    const bf16_t* g; bf16_t* act; const float* cw; const float* ssq;
    __device__ __forceinline__ void operator()(const f32x4 (&acc)[2][2][4][2], const Unit& u, int wr, int wc, int fr, int fq, PG8_LAS unsigned char* lds, int tid) const {
        const int rl0 = wr * 64 + fr; const int col0 = u.pn * BM + wc * 32 + 8 * fq;
        u32x4 gq[2][3];
#define E4_LOAD(p, buf) do { const int col_ = col0 + ((p) >> 3) * HALF; \
            const int row_ = u.pm * BM + rl0 + (((p) >> 2) & 1) * HALF + ((p) & 3) * 16; const int r1_ = row_ > 0 ? row_ - 1 : 0, r2_ = row_ > 1 ? row_ - 2 : 0; \
            gq[buf][0] = *(const u32x4*)(g + (size_t)row_ * DFF + col_); gq[buf][1] = *(const u32x4*)(g + (size_t)r1_ * DFF + col_); gq[buf][2] = *(const u32x4*)(g + (size_t)r2_ * DFF + col_); } while (0)
        E4_LOAD(0, 0);
        rstd_table(lds, ssq, u.pm, tid);
        const PG8_LAS float* RS = (const PG8_LAS float*)(lds + 131072);
        float c0[8], c1[8], c2[8];
#pragma unroll
        for (int p = 0; p < 16; ++p) {
            const int bj = p >> 3, ai = (p >> 2) & 1, m = p & 3;
            const int col = col0 + bj * HALF;
            if ((p & 7) == 0) {
                const f32x4 a0 = *(const f32x4*)(cw + col), a1 = *(const f32x4*)(cw + col + 4);
                const f32x4 b0 = *(const f32x4*)(cw + DFF + col), b1 = *(const f32x4*)(cw + DFF + col + 4);
                const f32x4 d0 = *(const f32x4*)(cw + 2 * DFF + col), d1 = *(const f32x4*)(cw + 2 * DFF + col + 4);
#pragma unroll
                for (int k = 0; k < 4; ++k) { c0[k] = a0[k]; c0[4 + k] = a1[k]; c1[k] = b0[k]; c1[4 + k] = b1[k]; c2[k] = d0[k]; c2[4 + k] = d1[k]; }
            }
            if (p + 1 < 16) E4_LOAD(p + 1, (p + 1) & 1);
            asm volatile("" ::: "memory");
            {
                const int rl = rl0 + ai * HALF + m * 16;
                const float sc = RS[rl];
                const u32x4 g0 = gq[p & 1][0], g1 = gq[p & 1][1], g2 = gq[p & 1][2];
                float o[8];
#pragma unroll
                for (int k = 0; k < 4; ++k) {
                    const float x0l = bf_lo(g0[k]), x0h = bf_hi(g0[k]), x1l = bf_lo(g1[k]), x1h = bf_hi(g1[k]), x2l = bf_lo(g2[k]), x2h = bf_hi(g2[k]);
                    const float gl = c0[2 * k] * x2l + c1[2 * k] * x1l + c2[2 * k] * x0l;
                    const float gh = c0[2 * k + 1] * x2h + c1[2 * k + 1] * x1h + c2[2 * k + 1] * x0h;
                    const float upl = (k < 2 ? acc[ai][bj][m][0][2 * k] : acc[ai][bj][m][1][2 * k - 4]) * sc;
                    const float uph = (k < 2 ? acc[ai][bj][m][0][2 * k + 1] : acc[ai][bj][m][1][2 * k - 3]) * sc;
                    o[2 * k] = gl * __builtin_amdgcn_rcpf(1.0f + __builtin_amdgcn_exp2f(-gl * LOG2E)) * upl;
                    o[2 * k + 1] = gh * __builtin_amdgcn_rcpf(1.0f + __builtin_amdgcn_exp2f(-gh * LOG2E)) * uph;
                }
                u32x4 w; w.x = cvt_pk_bf16(o[0], o[1]); w.y = cvt_pk_bf16(o[2], o[3]); w.z = cvt_pk_bf16(o[4], o[5]); w.w = cvt_pk_bf16(o[6], o[7]);
                *(u32x4*)(act + (size_t)(u.pm * BM + rl) * DFF + col) = w;
            }
            asm volatile("" ::: "memory");
        }
#undef E4_LOAD
    }
};

struct EpiGateUp {
    static constexpr bool PERM = true, AFTER_DRAIN = false, OVERLAP = true;
    bf16_t* act; const float* cw; const float* ssq;
    __device__ __forceinline__ void operator()(const f32x4 (&acc)[2][2][4][2], const Unit& u, int wr, int wc, int fr_in, int fq_in, PG8_LAS unsigned char* lds, int tid_in, int quad = -1) const {
        int fr = fr_in, fq = fq_in, tid = tid_in; asm volatile("" : "+v"(fr), "+v"(fq), "+v"(tid));
        const int rb = u.pm * 254 - 2 > 0 ? u.pm * 254 - 2 : 0;
        const int cl = wc * 32 + 8 * fq;
        PG8_LAS unsigned char* HB = lds + 131072 + 4096;
        if (fr >= 14) {
#pragma unroll
            for (int ai = 0; ai < 2; ++ai)
#pragma unroll
                for (int m = 0; m < 4; ++m) { const f32x4 v0 = acc[ai][0][m][0], v1 = acc[ai][0][m][1];
                    u32x4 w; w.x = cvt_pk_bf16(v0[0], v0[1]); w.y = cvt_pk_bf16(v0[2], v0[3]); w.z = cvt_pk_bf16(v1[0], v1[1]); w.w = cvt_pk_bf16(v1[2], v1[3]);
                    *(PG8_LAS u32x4*)(HB + (((ai * 8 + wr * 4 + m) * 2 + (fr - 14)) * 128 + cl) * 2) = w; }
        }
        {
            PG8_LAS float* RSw = (PG8_LAS float*)(lds + 131072);
            const int rl_ = tid >> 1, row_ = rb + rl_;
            const f32x4* p = (const f32x4*)(ssq + (size_t)row_ * 32 + (tid & 1) * 16);
            const f32x4 v0 = p[0], v1 = p[1], v2 = p[2], v3 = p[3];
            float s = (((v0[0] + v0[1]) + (v0[2] + v0[3])) + ((v1[0] + v1[1]) + (v1[2] + v1[3]))) + (((v2[0] + v2[1]) + (v2[2] + v2[3])) + ((v3[0] + v3[1]) + (v3[2] + v3[3])));
            const float o = __shfl_xor(s, 1);
            s = (tid & 1) ? o + s : s + o;
            if ((tid & 1) == 0) RSw[rl_] = (is_pad_row(row_) || row_ >= MT) ? 0.f : __builtin_amdgcn_rsqf(s * (1.0f / 2048.0f) + 1e-6f);
            asm volatile("s_waitcnt lgkmcnt(0)" ::: "memory"); __builtin_amdgcn_s_barrier(); asm volatile("" ::: "memory");
        }
        const PG8_LAS float* RS = (const PG8_LAS float*)(lds + 131072);
        const int col = u.pn * 128 + cl;
#pragma unroll
        for (int ai = 0; ai < 2; ++ai)
#pragma unroll
            for (int m = 0; m < 4; ++m) {
                const int rl = ai * HALF + wr * 64 + m * 16 + fr, gidx = ai * 8 + wr * 4 + m;
                const float sc = RS[rl], sc1 = RS[rl >= 1 ? rl - 1 : 0], sc2 = RS[rl >= 2 ? rl - 2 : 0];
                u32x4 h1 = (u32x4){0u, 0u, 0u, 0u}, h0 = h1;
                if (fr < 2 && gidx > 0) { h1 = *(const PG8_LAS u32x4*)(HB + (((gidx - 1) * 2 + 1) * 128 + cl) * 2); h0 = *(const PG8_LAS u32x4*)(HB + (((gidx - 1) * 2 + 0) * 128 + cl) * 2); }
                float o[8];
#pragma unroll
                for (int hf = 0; hf < 2; ++hf) {
                    const f32x4 w0 = *(const f32x4*)(cw + col + 4 * hf), w1 = *(const f32x4*)(cw + DFF + col + 4 * hf), w2 = *(const f32x4*)(cw + 2 * DFF + col + 4 * hf);
                    float cur[4], p1[4], p2[4];
#pragma unroll
                    for (int k = 0; k < 4; ++k) { cur[k] = acc[ai][0][m][hf][k] * sc;
                        p1[k] = __int_as_float(__builtin_amdgcn_update_dpp(__float_as_int(cur[k]), __float_as_int(cur[k]), 0x111, 0xf, 0xf, false));
                        p2[k] = __int_as_float(__builtin_amdgcn_update_dpp(__float_as_int(cur[k]), __float_as_int(cur[k]), 0x112, 0xf, 0xf, false)); }
                    if (fr < 2) {
                        const float e0 = bf_lo(h1[2 * hf]), e1 = bf_hi(h1[2 * hf]), e2 = bf_lo(h1[2 * hf + 1]), e3 = bf_hi(h1[2 * hf + 1]);
                        if (fr == 0) {
                            p1[0] = e0 * sc1; p1[1] = e1 * sc1; p1[2] = e2 * sc1; p1[3] = e3 * sc1;
                            p2[0] = bf_lo(h0[2 * hf]) * sc2; p2[1] = bf_hi(h0[2 * hf]) * sc2; p2[2] = bf_lo(h0[2 * hf + 1]) * sc2; p2[3] = bf_hi(h0[2 * hf + 1]) * sc2;
                        } else { p2[0] = e0 * sc2; p2[1] = e1 * sc2; p2[2] = e2 * sc2; p2[3] = e3 * sc2; }
                    }
#pragma unroll
                    for (int k = 0; k < 4; ++k) {
                        const float gc = w0[k] * p2[k] + w1[k] * p1[k] + w2[k] * cur[k];
                        const float upv = acc[ai][1][m][hf][k] * sc;
                        o[4 * hf + k] = gc * __builtin_amdgcn_rcpf(1.0f + __builtin_amdgcn_exp2f(-gc * LOG2E)) * upv;
                    }
                }
                const int row = rb + rl;
                if ((u.pm == 0 ? rl < 254 : rl >= 2) && row < MT) {
                    u32x4 w; w.x = cvt_pk_bf16(o[0], o[1]); w.y = cvt_pk_bf16(o[2], o[3]); w.z = cvt_pk_bf16(o[4], o[5]); w.w = cvt_pk_bf16(o[6], o[7]);
                    *(u32x4*)(act + (size_t)row * DFF + col) = w;
                }
            }
    }
};

template <class Final> struct EpiSplitK {
    static constexpr bool PERM = Final::PERM, AFTER_DRAIN = true, OVERLAP = false;
    Final fin; float* partials; unsigned* cnt;
    __device__ __forceinline__ void fused(f32x4 (&acc)[2][2][4][2], const Unit& u, int wr, int wc, int fr, int fq, PG8_LAS unsigned char* lds, int tid) const {
        const int slot = (int)blockIdx.x >> 2;
        f32x4* mine = (f32x4*)(partials + ((size_t)slot * 4 + u.ks) * 65536) + tid;
#pragma unroll
        for (int ai = 0; ai < 2; ++ai)
#pragma unroll
            for (int bj = 0; bj < 2; ++bj)
#pragma unroll
                for (int m = 0; m < 4; ++m)
#pragma unroll
                    for (int n = 0; n < 2; ++n) mine[(size_t)(((ai * 2 + bj) * 4 + m) * 2 + n) * 512] = acc[ai][bj][m][n];
        asm volatile("s_waitcnt vmcnt(0)" ::: "memory");
        __builtin_amdgcn_s_barrier();
        if (tid == 0) {
            __builtin_amdgcn_fence(__ATOMIC_RELEASE, "agent");
            asm volatile("s_waitcnt vmcnt(0)" ::: "memory");
            (void)__hip_atomic_fetch_add(cnt + slot, 1u, __ATOMIC_RELAXED, __HIP_MEMORY_SCOPE_AGENT);
            unsigned sp = 0;
            while (__hip_atomic_load(cnt + slot, __ATOMIC_RELAXED, __HIP_MEMORY_SCOPE_AGENT) < 4u) { __builtin_amdgcn_s_sleep(1); if (++sp > (1u << 22)) break; }
            __builtin_amdgcn_fence(__ATOMIC_ACQUIRE, "agent");
            asm volatile("s_waitcnt vmcnt(0)" ::: "memory");
        }
        asm volatile("" ::: "memory"); __builtin_amdgcn_s_barrier(); asm volatile("" ::: "memory");
        const int qa = u.ks >> 1, qm = (u.ks & 1) * 2;
        const f32x4* base = (const f32x4*)(partials + (size_t)slot * 4 * 65536) + tid;
#pragma unroll
        for (int bj = 0; bj < 2; ++bj) {
            f32x4 pp[2][2][4];
#pragma unroll
            for (int mm = 0; mm < 2; ++mm)
#pragma unroll
                for (int n = 0; n < 2; ++n)
#pragma unroll
                    for (int sl = 0; sl < 4; ++sl) pp[mm][n][sl] = base[(size_t)sl * 16384 + (size_t)(((qa * 2 + bj) * 4 + qm + mm) * 2 + n) * 512];
#pragma unroll
            for (int ai = 0; ai < 2; ++ai)
#pragma unroll
                for (int mh = 0; mh < 2; ++mh)
                    if (ai == qa && mh * 2 == qm) {
#pragma unroll
                        for (int mm = 0; mm < 2; ++mm)
#pragma unroll
                            for (int n = 0; n < 2; ++n) acc[ai][bj][mh * 2 + mm][n] = ((pp[mm][n][0] + pp[mm][n][1]) + pp[mm][n][2]) + pp[mm][n][3];
                    }
            asm volatile("" ::: "memory");
        }
        fin(acc, u, wr, wc, fr, fq, lds, tid, (int)u.ks);
    }
};

template <class Epi, class Sched, bool ALIGN_EPI = false, bool SP2 = false>
__device__ __forceinline__ void gemm_phase(PG8_LAS unsigned char* lds, const Gemm g, const Sched& S, const Epi& E) {
    int tid = threadIdx.x; asm volatile("" : "+v"(tid));
    const int wid = __builtin_amdgcn_readfirstlane(tid >> 6), lane = tid & 63, wr = wid >> 2, wc = wid & 3, fr = lane & 15, fq = lane >> 4;
    const int K = g.K, nt = K / BK;
    unsigned voffA[2], voffB[2];
#pragma unroll
    for (int i = 0; i < 2; ++i) { int R, C; stage_rc(tid * 16 + i * 8192, R, C); const int Rb = Epi::PERM ? ((R & ~31) + perm32(R & 31)) : R;
        voffA[i] = (unsigned)(R * g.ld + C) * 2u; voffB[i] = (unsigned)(Rb * g.ld + C) * 2u; }
    const size_t kstep = (size_t)(BK * 2);
    const size_t hstep = (size_t)HALF * g.ld * 2;
    const size_t tstep = 2 * hstep;
    const unsigned ldsw = (unsigned)wid * 1024u;
    const int aoff = lds_byte(wr * 64 + fr, fq * 8), boff = lds_byte(wc * 32 + fr, fq * 8);
#define PG8_SA(b, h) (((b) * 2 + (h)) * HTB)
#define PG8_SB(b, h) ((4 + (b) * 2 + (h)) * HTB)
#define PG8_STAGE(bufoff, gbase, voff) do { _Pragma("unroll") for (int _i = 0; _i < 2; ++_i) \
        __builtin_amdgcn_global_load_lds((const unsigned*)((const char*)(gbase) + (voff)[_i]), (PG8_LAS unsigned*)(lds + (bufoff) + ldsw + _i * 8192), 16, 0, 0); } while (0)
#define PG8_LDA(dst, b, h) do { _Pragma("unroll") for (int m = 0; m < 4; ++m) _Pragma("unroll") for (int k = 0; k < 2; ++k) dst[m][k] = *(const PG8_LAS bf16x8*)(lds + PG8_SA(b, h) + aoff + m * 2048 + k * 1024); } while (0)
#define PG8_LDB(dst, b, h) do { _Pragma("unroll") for (int n = 0; n < 2; ++n) _Pragma("unroll") for (int k = 0; k < 2; ++k) dst[n][k] = *(const PG8_LAS bf16x8*)(lds + PG8_SB(b, h) + boff + n * 2048 + k * 1024); } while (0)
#define PG8_MMA(ai, bj, At, Bt) do { __builtin_amdgcn_s_setprio(1); _Pragma("unroll") for (int m = 0; m < 4; ++m) _Pragma("unroll") for (int n = 0; n < 2; ++n) _Pragma("unroll") for (int k = 0; k < 2; ++k) \
        acc[ai][bj][m][n] = __builtin_amdgcn_mfma_f32_16x16x32_bf16(Bt[n][k], At[m][k], acc[ai][bj][m][n], 0, 0, 0); __builtin_amdgcn_s_setprio(0); } while (0)
#define PG8_WAIT_V(n) asm volatile("s_waitcnt vmcnt(" #n ")" ::: "memory")
#define PG8_WAIT_L(n) asm volatile("s_waitcnt lgkmcnt(" #n ")" ::: "memory")
#define PG8_BAR __builtin_amdgcn_s_barrier()
#define PG8_SCHED __builtin_amdgcn_sched_barrier(0)
    Unit cur, nxt; int ui = 0;
    if (!S.next(0, cur)) return;
    f32x4 acc[2][2][4][2];
#pragma unroll
    for (int a = 0; a < 2; ++a)
#pragma unroll
        for (int b = 0; b < 2; ++b)
#pragma unroll
            for (int m = 0; m < 4; ++m)
#pragma unroll
                for (int n = 0; n < 2; ++n) acc[a][b][m][n] = (f32x4){0.f, 0.f, 0.f, 0.f};
    bf16x8 At[4][2], B0[2][2], B1[2][2];
#define PG8_AROW(pm_) (Epi::OVERLAP ? (size_t)((pm_) * 254 - 2 > 0 ? (pm_) * 254 - 2 : 0) * ((size_t)g.ld * 2) : (size_t)(pm_) * tstep)
    const char* cA = (const char*)g.A + PG8_AROW(cur.pm) + (size_t)cur.ks * K * 2; const char* cB = (const char*)g.Bt + (size_t)cur.pn * tstep + (size_t)cur.ks * K * 2;
    S.a_ready(cur);
    if constexpr (SP2) {
        PG8_STAGE(PG8_SB(0, 0), cB, voffB); PG8_STAGE(PG8_SB(0, 1), cB + hstep, voffB); PG8_STAGE(PG8_SA(0, 0), cA, voffA); PG8_STAGE(PG8_SA(0, 1), cA + hstep, voffA);
        if (wr == 1) PG8_BAR;
        PG8_WAIT_V(2); PG8_BAR;
        PG8_STAGE(PG8_SB(1, 0), cB + kstep, voffB); PG8_STAGE(PG8_SA(1, 0), cA + kstep, voffA); PG8_STAGE(PG8_SB(1, 1), cB + hstep + kstep, voffB);
        PG8_WAIT_V(6); PG8_BAR;
    } else {
        PG8_STAGE(PG8_SB(0, 0), cB, voffB); PG8_STAGE(PG8_SA(0, 0), cA, voffA); PG8_STAGE(PG8_SB(0, 1), cB + hstep, voffB); PG8_STAGE(PG8_SA(0, 1), cA + hstep, voffA);
        if (wr == 1) PG8_BAR;
        PG8_WAIT_V(4); PG8_BAR;
        PG8_STAGE(PG8_SB(1, 0), cB + kstep, voffB); PG8_STAGE(PG8_SA(1, 0), cA + kstep, voffA); PG8_STAGE(PG8_SB(1, 1), cB + hstep + kstep, voffB);
        PG8_WAIT_V(6); PG8_BAR;
    }
    for (;;) {
        const bool has_next = S.next(ui + 1, nxt);
        const char* nA = has_next ? (const char*)g.A + PG8_AROW(nxt.pm) + (size_t)nxt.ks * K * 2 : cA; const char* nB = has_next ? (const char*)g.Bt + (size_t)nxt.pn * tstep + (size_t)nxt.ks * K * 2 : cB;
        for (int t = 0; t < nt; t += 2) {
            const bool last = (t == nt - 2);
            const char* a1 = cA + (size_t)(t + 1) * kstep;
            const char* a2 = last ? nA : cA + (size_t)(t + 2) * kstep; const char* b2 = last ? nB : cB + (size_t)(t + 2) * kstep;
            const char* a3 = a2 + kstep; const char* b3 = b2 + kstep;
            if (last && has_next) S.a_ready(nxt);
            if constexpr (SP2) {
            PG8_LDB(B0, 0, 0); PG8_LDB(B1, 0, 1); PG8_SCHED; PG8_LDA(At, 0, 0); PG8_STAGE(PG8_SA(1, 1), a1 + hstep, voffA);
            PG8_WAIT_V(8); PG8_WAIT_L(0); PG8_BAR; PG8_MMA(0, 0, At, B0); PG8_MMA(0, 1, At, B1); PG8_BAR; PG8_SCHED;
            PG8_LDA(At, 0, 1); PG8_STAGE(PG8_SB(0, 0), b2, voffB); PG8_STAGE(PG8_SB(0, 1), b2 + hstep, voffB); PG8_STAGE(PG8_SA(0, 0), a2, voffA);
            PG8_WAIT_V(8); PG8_WAIT_L(0); PG8_BAR; PG8_MMA(1, 0, At, B0); PG8_MMA(1, 1, At, B1); PG8_BAR; PG8_SCHED;
            PG8_LDB(B0, 1, 0); PG8_LDB(B1, 1, 1); PG8_SCHED; PG8_LDA(At, 1, 0); PG8_STAGE(PG8_SA(0, 1), a2 + hstep, voffA);
            PG8_WAIT_V(8); PG8_WAIT_L(0); PG8_BAR; PG8_MMA(0, 0, At, B0); PG8_MMA(0, 1, At, B1); PG8_BAR; PG8_SCHED;
            PG8_LDA(At, 1, 1); PG8_STAGE(PG8_SB(1, 0), b3, voffB); PG8_STAGE(PG8_SB(1, 1), b3 + hstep, voffB); PG8_STAGE(PG8_SA(1, 0), a3, voffA);
            PG8_WAIT_V(8); PG8_WAIT_L(0); PG8_BAR; PG8_MMA(1, 0, At, B0); PG8_MMA(1, 1, At, B1); PG8_BAR; PG8_SCHED;
            } else {
            PG8_LDB(B0, 0, 0); PG8_SCHED; PG8_LDA(At, 0, 0); PG8_STAGE(PG8_SA(1, 1), a1 + hstep, voffA);
            PG8_WAIT_L(8); PG8_BAR; PG8_WAIT_L(0); PG8_MMA(0, 0, At, B0); PG8_BAR; PG8_SCHED;
            PG8_LDB(B1, 0, 1); PG8_STAGE(PG8_SB(0, 0), b2, voffB);
            PG8_BAR; PG8_WAIT_L(0); PG8_MMA(0, 1, At, B1); PG8_BAR;
            PG8_LDA(At, 0, 1); PG8_STAGE(PG8_SA(0, 0), a2, voffA);
            PG8_BAR; PG8_WAIT_L(0); PG8_MMA(1, 0, At, B0); PG8_BAR; PG8_SCHED;
            PG8_STAGE(PG8_SB(0, 1), b2 + hstep, voffB);
            PG8_WAIT_V(6); PG8_BAR; PG8_MMA(1, 1, At, B1); PG8_BAR;
            PG8_LDB(B0, 1, 0); PG8_SCHED; PG8_LDA(At, 1, 0); PG8_STAGE(PG8_SA(0, 1), a2 + hstep, voffA);
            PG8_WAIT_L(8); PG8_BAR; PG8_WAIT_L(0); PG8_MMA(0, 0, At, B0); PG8_BAR; PG8_SCHED;
            PG8_LDB(B1, 1, 1); PG8_STAGE(PG8_SB(1, 0), b3, voffB);
            PG8_BAR; PG8_WAIT_L(0); PG8_MMA(0, 1, At, B1); PG8_BAR;
            PG8_LDA(At, 1, 1); PG8_STAGE(PG8_SA(1, 0), a3, voffA);
            PG8_BAR; PG8_WAIT_L(0); PG8_MMA(1, 0, At, B0); PG8_BAR; PG8_SCHED;
            PG8_STAGE(PG8_SB(1, 1), b3 + hstep, voffB);
            PG8_WAIT_V(6); PG8_BAR; PG8_MMA(1, 1, At, B1); PG8_BAR;
            }
        }
        if constexpr (ALIGN_EPI) { if (wr == 0) PG8_BAR; }
        if constexpr (!Epi::AFTER_DRAIN) { E(acc, cur, wr, wc, fr, fq, lds, tid); S.done(cur); }
        if (!has_next) break;
#pragma unroll
        for (int a = 0; a < 2; ++a)
#pragma unroll
            for (int b = 0; b < 2; ++b)
#pragma unroll
                for (int m = 0; m < 4; ++m)
#pragma unroll
                    for (int n = 0; n < 2; ++n) acc[a][b][m][n] = (f32x4){0.f, 0.f, 0.f, 0.f};
        cur = nxt; cA = nA; cB = nB; ++ui;
        if constexpr (ALIGN_EPI) { if (wr == 1) PG8_BAR; }
    }
    PG8_WAIT_V(0);
    if constexpr (!ALIGN_EPI) { if (wr == 0) PG8_BAR; }
    PG8_BAR;
    if constexpr (Epi::AFTER_DRAIN) { E.fused(acc, cur, wr, wc, fr, fq, lds, tid); S.done(cur); }
#undef PG8_AROW
#undef PG8_SA
#undef PG8_SB
#undef PG8_STAGE
#undef PG8_LDA
#undef PG8_LDB
#undef PG8_MMA
#undef PG8_WAIT_V
#undef PG8_WAIT_L
#undef PG8_BAR
#undef PG8_SCHED
}
}

#define MFMA32(a, b, c) __builtin_amdgcn_mfma_f32_32x32x16_bf16((a), (b), (c), 0, 0, 0)
__device__ __forceinline__ int crow(int reg, int h) { return (reg & 3) + 8 * (reg >> 2) + 4 * h; }
__device__ __forceinline__ s16x4 tr_read(const LAS unsigned char* p) { return __builtin_bit_cast(s16x4, __builtin_amdgcn_ds_read_tr16_b64_v4i16((LAS s16x4*)p)); }
__device__ __forceinline__ bf16x8 cat8(s16x4 lo, s16x4 hi) { return __builtin_shufflevector(lo, hi, 0, 1, 2, 3, 4, 5, 6, 7); }
__device__ __forceinline__ bf16x8 pack_step(const f32x16& x, int s) {
    u32x4 p;
    p.x = cvt_pk_bf16(x[8 * s + 0], x[8 * s + 1]); p.y = cvt_pk_bf16(x[8 * s + 2], x[8 * s + 3]);
    p.z = cvt_pk_bf16(x[8 * s + 4], x[8 * s + 5]); p.w = cvt_pk_bf16(x[8 * s + 6], x[8 * s + 7]);
    return __builtin_bit_cast(bf16x8, p);
}
__device__ __forceinline__ f32x16 zero16() { f32x16 z;
#pragma unroll
    for (int i = 0; i < 16; ++i) z[i] = 0.f; return z; }

namespace att {
constexpr int KSTR = 272, VSTR = 320;
constexpr int KSLOTB = 64 * KSTR, VSLOTB = 64 * VSTR;
constexpr int L_VRING = 2 * KSLOTB;
constexpr int L_X = 2 * KSLOTB + 2 * VSLOTB, XREG = 16896;
constexpr float THR = 6.0f;
#define ATT_BAR() asm volatile("s_waitcnt lgkmcnt(0)\n\ts_barrier" ::: "memory")
__device__ __forceinline__ unsigned scale_pk(unsigned w, float c) { return cvt_pk_bf16(bf_lo(w) * c, bf_hi(w) * c); }
__device__ __forceinline__ void kmax_unit(const bf16_t* __restrict__ proj, unsigned* __restrict__ kmax2, int u) {
    int tid = threadIdx.x; asm volatile("" : "+v"(tid));
    const int combo = u >> 2, quarter = u & 3, b = combo >> 4, h = (combo >> 1) & 7, map = combo & 1;
    float best = 0.f;
    for (int t = quarter * 1056 + tid; t < (quarter + 1) * 1056; t += 512) {
        const u32x4* p = (const u32x4*)(proj + ((size_t)b * LTOK + t) * DIN + C_AK + h * 128 + map * 64);
        float ss = 0.f;
#pragma unroll
        for (int c = 0; c < 8; ++c) { const u32x4 w = p[c];
#pragma unroll
            for (int k = 0; k < 4; ++k) { const float lo = bf_lo(w[k]), hi = bf_hi(w[k]); ss += lo * lo + hi * hi; } }
        best = fmaxf(best, ss);
    }
#pragma unroll
    for (int o = 1; o < 64; o <<= 1) best = fmaxf(best, __shfl_xor(best, o));
    if ((tid & 63) == 0) atomicMax(kmax2 + combo, __float_as_uint(best));
}
__device__ __forceinline__ void attn_unit(LAS unsigned char* lds, const bf16_t* __restrict__ proj, bf16_t* __restrict__ y, int b, int h, int qb,
                                          float lam, const float* __restrict__ subln, float post_scale, const unsigned* __restrict__ kmax2) {
    int tid = threadIdx.x; asm volatile("" : "+v"(tid));
    const int lane = tid & 63, wid = __builtin_amdgcn_readfirstlane(tid >> 6);
    const int map = wid & 1, g = wid >> 1, r = lane & 31, hh = lane >> 5;
    const int g16 = (lane >> 4) & 1, q4 = (lane & 15) >> 2, p4 = lane & 3;
    const size_t rowbase = (size_t)b * LTOK; const int q0 = qb * CH;
    const int qpos = q0 + g * 32 + r;
    const float slope = __builtin_amdgcn_exp2f(-(float)(h + 1));
    const float c1 = 0.125f * LOG2E, c2 = slope * LOG2E;
    bf16x8 qf[4];
    float qn2 = 0.f;
    { const bf16_t* qp = proj + (rowbase + qpos) * DIN + C_AQ + h * 128 + map * 64 + hh * 8;
#pragma unroll
      for (int s = 0; s < 4; ++s) { u32x4 w = *(const u32x4*)(qp + s * 16); w.x = scale_pk(w.x, c1); w.y = scale_pk(w.y, c1); w.z = scale_pk(w.z, c1); w.w = scale_pk(w.w, c1); qf[s] = __builtin_bit_cast(bf16x8, w);
#pragma unroll
          for (int k = 0; k < 4; ++k) { const float lo = bf_lo(w[k]), hi = bf_hi(w[k]); qn2 += lo * lo + hi * hi; } } }
    qn2 += __shfl_xor(qn2, 32);
    const float ub0 = sqrtf(qn2) * sqrtf(__uint_as_float(kmax2[(b * 8 + h) * 2 + map])) * 1.002f + 1.0f + c2 * (float)(63 - qpos) + 160.0f;
    LAS volatile unsigned char* FLG = (LAS volatile unsigned char*)(lds + LDS_MISC + 96);
    f32x16 o[4];
#pragma unroll
    for (int t = 0; t < 4; ++t) o[t] = zero16();
    float m_ref = 0.f, l_run = 0.f;
    const int jend = 2 * qb + 1;
    const int skey = tid >> 4, sc = tid & 15;
    const bf16_t* kg = proj + (rowbase + skey) * DIN + C_AK + h * 128 + sc * 8;
    const bf16_t* vg = proj + (rowbase + skey) * DIN + C_AV + h * 128 + sc * 8;
    u32x4 kreg[2], vreg[2];
#define LOADK(j) do { _Pragma("unroll") for (int i_ = 0; i_ < 2; ++i_) kreg[i_] = *(const u32x4*)(kg + (size_t)((j) * 64 + 32 * i_) * DIN); } while (0)
#define LOADV(j) do { _Pragma("unroll") for (int i_ = 0; i_ < 2; ++i_) vreg[i_] = *(const u32x4*)(vg + (size_t)((j) * 64 + 32 * i_) * DIN); } while (0)
#define STOREK(j) do { _Pragma("unroll") for (int i_ = 0; i_ < 2; ++i_) *(LAS u32x4*)(lds + ((j) & 1) * KSLOTB + (skey + 32 * i_) * KSTR + sc * 16) = kreg[i_]; } while (0)
#define STOREV(j) do { _Pragma("unroll") for (int i_ = 0; i_ < 2; ++i_) *(LAS u32x4*)(lds + L_VRING + ((j) & 1) * VSLOTB + (skey + 32 * i_) * VSTR + sc * 16) = vreg[i_]; } while (0)
    const int kAo = r * KSTR + map * 128 + hh * 16;
    const int vAo = L_VRING + (4 * hh + q4) * VSTR + 32 * g16 + 8 * p4;
    f32x16 s0, s1; float mx;
#define QK_TILE(jt) do { \
        const LAS unsigned char* kA0_ = lds + ((jt) & 1) * KSLOTB + kAo; bf16x8 kf_[4]; \
        _Pragma("unroll") for (int s_ = 0; s_ < 2; ++s_) { kf_[2 * s_] = *(const LAS bf16x8*)(kA0_ + s_ * 32); kf_[2 * s_ + 1] = *(const LAS bf16x8*)(kA0_ + 32 * KSTR + s_ * 32); } \
        const float base0_ = c2 * (float)((jt) * 64 + 4 * hh - qpos) - m_ref, base1_ = base0_ + 32.0f * c2; \
        _Pragma("unroll") for (int i_ = 0; i_ < 16; ++i_) { const float kq_ = (float)((i_ & 3) + 8 * (i_ >> 2)); s0[i_] = __builtin_fmaf(c2, kq_, base0_); s1[i_] = __builtin_fmaf(c2, kq_, base1_); } \
        __builtin_amdgcn_sched_barrier(0); \
        _Pragma("unroll") for (int s_ = 0; s_ < 2; ++s_) { s0 = MFMA32(kf_[2 * s_], qf[s_], s0); s1 = MFMA32(kf_[2 * s_ + 1], qf[s_], s1); } \
        _Pragma("unroll") for (int s_ = 0; s_ < 2; ++s_) { kf_[2 * s_] = *(const LAS bf16x8*)(kA0_ + (s_ + 2) * 32); kf_[2 * s_ + 1] = *(const LAS bf16x8*)(kA0_ + 32 * KSTR + (s_ + 2) * 32); } \
        __builtin_amdgcn_sched_barrier(0); \
        _Pragma("unroll") for (int s_ = 0; s_ < 2; ++s_) { s0 = MFMA32(kf_[2 * s_], qf[s_ + 2], s0); s1 = MFMA32(kf_[2 * s_ + 1], qf[s_ + 2], s1); } \
        __builtin_amdgcn_sched_barrier(0); \
        if ((jt) == 1 || (jt) >= 2 * qb) { const int kb_ = (jt) * 64 + 4 * hh; \
            _Pragma("unroll") for (int i_ = 0; i_ < 16; ++i_) { const int k0_ = kb_ + (i_ & 3) + 8 * (i_ >> 2), k1_ = k0_ + 32; \
                s0[i_] = (k0_ <= qpos && k0_ >= PADF) ? s0[i_] : -1e30f; s1[i_] = (k1_ <= qpos && k1_ >= PADF) ? s1[i_] : -1e30f; } } \
        mx = fmaxf(s0[0], s1[0]); \
        _Pragma("unroll") for (int i_ = 1; i_ < 16; ++i_) mx = fmaxf(fmaxf(mx, s0[i_]), s1[i_]); \
        mx = fmaxf(mx, __shfl_xor(mx, 32)); } while (0)
    bf16x8 pb[4];
    LOADK(jend); LOADV(jend);
    ATT_BAR();
    STOREK(jend); STOREV(jend);
    if (jend >= 2) LOADK(jend - 1);
    if (lane == 0) { FLG[wid] = 0; FLG[8 + wid] = 0; }
    ATT_BAR();
    QK_TILE(jend);
    m_ref = mx > -1e29f ? mx : 0.f;
    { float ls = 0.f;
#pragma unroll
      for (int i = 0; i < 16; ++i) { s0[i] = __builtin_amdgcn_exp2f(s0[i] - m_ref); s1[i] = __builtin_amdgcn_exp2f(s1[i] - m_ref); ls += s0[i] + s1[i]; }
      l_run = ls; }
    pb[0] = pack_step(s0, 0); pb[1] = pack_step(s0, 1); pb[2] = pack_step(s1, 0); pb[3] = pack_step(s1, 1);
    if (jend >= 2) { STOREK(jend - 1); LOADV(jend - 1); if (jend >= 3) LOADK(jend - 2); }
    ATT_BAR();
#define ATT_VLOADH(hs, buf) do { const LAS unsigned char* vp_ = vA + ((((hs) >> 1) >> 1) * 32 + 16 * (((hs) >> 1) & 1)) * VSTR + ((hs) & 1) * 128; \
        _Pragma("unroll") for (int t_ = 0; t_ < 2; ++t_) vah[buf][t_] = cat8(tr_read(vp_ + t_ * 64), tr_read(vp_ + 8 * VSTR + t_ * 64)); } while (0)
    int j = jend;
    for (;; --j) {
        bool more = j > 1;
        if (more && j != jend) {
            const unsigned v0 = *(LAS volatile unsigned*)(FLG + ((j + 1) & 1) * 8), v1 = *(LAS volatile unsigned*)(FLG + ((j + 1) & 1) * 8 + 4);
            more = !(v0 == 0x01010101u && v1 == 0x01010101u);
        }
        if (!more) break;
        const LAS unsigned char* vA = lds + (j & 1) * VSLOTB + vAo;
        bf16x8 vah[2][2];
        QK_TILE(j - 1);
        ATT_VLOADH(0, 0); ATT_VLOADH(1, 1);
        __builtin_amdgcn_sched_barrier(0);
        float ls = 0.f;
#pragma unroll
        for (int hs = 0; hs < 8; ++hs) {
#pragma unroll
            for (int t = 0; t < 2; ++t) o[2 * (hs & 1) + t] = MFMA32(vah[hs & 1][t], pb[hs >> 1], o[2 * (hs & 1) + t]);
            if (hs + 2 < 8) ATT_VLOADH(hs + 2, hs & 1);
#pragma unroll
            for (int i = 2 * hs; i < 2 * hs + 2; ++i) { s0[i] = __builtin_amdgcn_exp2f(s0[i]); s1[i] = __builtin_amdgcn_exp2f(s1[i]); ls += s0[i] + s1[i]; }
            __builtin_amdgcn_sched_barrier(0);
        }
        l_run += ls;
        if (__any(mx > THR)) {
            const float dl = fmaxf(mx, 0.f);
            m_ref += dl;
            const float alpha = __builtin_amdgcn_exp2f(-dl);
            l_run *= alpha;
#pragma unroll
            for (int i = 0; i < 16; ++i) { s0[i] *= alpha; s1[i] *= alpha; }
#pragma unroll
            for (int t = 0; t < 4; ++t)
#pragma unroll
                for (int i = 0; i < 16; ++i) o[t][i] *= alpha;
        }
        pb[0] = pack_step(s0, 0); pb[1] = pack_step(s0, 1); pb[2] = pack_step(s1, 0); pb[3] = pack_step(s1, 1);
        STOREV(j - 1);
        if (j - 1 > 1) { STOREK(j - 2); LOADV(j - 2); if (j - 2 > 1) LOADK(j - 3); }
        {
            const bool skip = __all(ub0 + c2 * 64.0f * (float)(j - 2) - m_ref < 0.f);
            if (lane == 0) FLG[(j & 1) * 8 + wid] = skip ? 1 : 0;
        }
        ATT_BAR();
    }
    {
        const LAS unsigned char* vA = lds + (j & 1) * VSLOTB + vAo;
        bf16x8 vah[2][2];
        ATT_VLOADH(0, 0); ATT_VLOADH(1, 1);
#pragma unroll
        for (int hs = 0; hs < 8; ++hs) {
#pragma unroll
            for (int t = 0; t < 2; ++t) o[2 * (hs & 1) + t] = MFMA32(vah[hs & 1][t], pb[hs >> 1], o[2 * (hs & 1) + t]);
            if (hs + 2 < 8) ATT_VLOADH(hs + 2, hs & 1);
            __builtin_amdgcn_sched_barrier(0);
        }
    }
#undef ATT_VLOADH
#undef LOADK
#undef LOADV
#undef STOREK
#undef STOREV
#undef QK_TILE
    const float l_tot = l_run + __shfl_xor(l_run, 32);
    const float inv = l_tot > 0.f ? 1.0f / l_tot : 0.f;
    LAS float* X = (LAS float*)(lds + L_X + g * XREG);
    if (map == 1) {
#pragma unroll
        for (int t = 0; t < 4; ++t)
#pragma unroll
            for (int i = 0; i < 16; ++i) X[(t * 16 + i) * 64 + lane] = o[t][i] * inv;
    }
    ATT_BAR();
    if (map == 0) {
        float ss = 0.f;
#pragma unroll
        for (int t = 0; t < 4; ++t)
#pragma unroll
            for (int i = 0; i < 16; ++i) { const float v = o[t][i] * inv - lam * X[(t * 16 + i) * 64 + lane]; o[t][i] = v; ss += v * v; }
        ss += __shfl_xor(ss, 32);
        const float rstd = __builtin_amdgcn_rsqf(ss * (1.0f / 128.0f) + EPS) * post_scale;
        asm volatile("s_waitcnt lgkmcnt(0)" ::: "memory");
#pragma unroll
        for (int t = 0; t < 4; ++t)
#pragma unroll
            for (int gq = 0; gq < 4; ++gq) {
                const f32x4 v = (f32x4){o[t][4 * gq] * rstd, o[t][4 * gq + 1] * rstd, o[t][4 * gq + 2] * rstd, o[t][4 * gq + 3] * rstd};
                *(LAS f32x4*)(X + r * 132 + t * 32 + 8 * gq + 4 * hh) = v;
            }
        asm volatile("s_waitcnt lgkmcnt(0)" ::: "memory");
        const int ch = lane & 15;
        const f32x4 w0 = *(const f32x4*)(subln + ch * 8), w1 = *(const f32x4*)(subln + ch * 8 + 4);
#pragma unroll
        for (int p = 0; p < 8; ++p) {
            const int row = p * 4 + (lane >> 4);
            const f32x4 v0 = *(const LAS f32x4*)(X + row * 132 + ch * 8) * w0, v1 = *(const LAS f32x4*)(X + row * 132 + ch * 8 + 4) * w1;
            u32x4 w; w.x = cvt_pk_bf16(v0[0], v0[1]); w.y = cvt_pk_bf16(v0[2], v0[3]); w.z = cvt_pk_bf16(v1[0], v1[1]); w.w = cvt_pk_bf16(v1[2], v1[3]);
            *(u32x4*)(y + (rowbase + q0 + g * 32 + row) * DM + h * 128 + ch * 8) = w;
        }
    }
    ATT_BAR();
}
}

namespace ret {
constexpr int KSTR = 320, VSTR = 576;
constexpr int L_K = 0, L_V = 128 * KSTR;
constexpr int M_V = 0, M_T = 0, TSTR = 260, M_SS = 128 * TSTR * 4;
__device__ __forceinline__ float log2gamma(int h) { return __builtin_log2f(1.0f - __builtin_amdgcn_exp2f(-(float)(5 + h))); }

__device__ __forceinline__ void kv_unit(LAS unsigned char* lds, const bf16_t* __restrict__ proj, bf16_t* __restrict__ kvT, int b, int h, int n) {
    int tid = threadIdx.x; asm volatile("" : "+v"(tid));
    const int lane = tid & 63, wid = __builtin_amdgcn_readfirstlane(tid >> 6);
    const int r = lane & 31, hh = lane >> 5, g16 = (lane >> 4) & 1, q4 = (lane & 15) >> 2, p4 = lane & 3;
    const size_t row0 = (size_t)b * LTOK + (size_t)n * CH;
    const float l2g = log2gamma(h);
    __syncthreads();
#pragma unroll
    for (int i = 0; i < 4; ++i) {
        const int j = (tid >> 4) + 32 * i, c = tid & 15;
        const u32x4 kk = *(const u32x4*)(proj + (row0 + j) * DIN + C_RK + h * 128 + c * 8);
        const float dec = __builtin_amdgcn_exp2f(l2g * (float)(127 - j)) * 0.08838834764831845f;
        u32x4 w;
#pragma unroll
        for (int k = 0; k < 4; ++k) w[k] = cvt_pk_bf16(bf_lo(kk[k]) * dec, bf_hi(kk[k]) * dec);
        *(LAS u32x4*)(lds + L_K + j * KSTR + c * 16) = w;
    }
#pragma unroll
    for (int i = 0; i < 8; ++i) {
        const int j = (tid >> 5) + 16 * i, c = tid & 31;
        const u32x4 vv = *(const u32x4*)(proj + (row0 + j) * DIN + C_RV + h * 256 + c * 8);
        *(LAS u32x4*)(lds + L_V + j * VSTR + c * 16) = vv;
    }
    __syncthreads();
    f32x16 acc[4];
#pragma unroll
    for (int t = 0; t < 4; ++t) acc[t] = zero16();
    const LAS unsigned char* va = lds + L_V + (8 * hh + q4) * VSTR + (32 * wid + 16 * g16) * 2 + 8 * p4;
    const LAS unsigned char* ka = lds + L_K + (8 * hh + q4) * KSTR + (16 * g16) * 2 + 8 * p4;
    bf16x8 fa[2], fb[2][4];
#define KV_FRAGS(s, buf) do { fa[buf] = cat8(tr_read(va + (16 * (s)) * VSTR), tr_read(va + (16 * (s) + 4) * VSTR)); \
        _Pragma("unroll") for (int t_ = 0; t_ < 4; ++t_) fb[buf][t_] = cat8(tr_read(ka + (16 * (s)) * KSTR + t_ * 64), tr_read(ka + (16 * (s) + 4) * KSTR + t_ * 64)); } while (0)
    KV_FRAGS(0, 0);
#pragma unroll
    for (int s = 0; s < 8; ++s) {
        if (s + 1 < 8) KV_FRAGS(s + 1, (s + 1) & 1);
        __builtin_amdgcn_sched_barrier(0);
#pragma unroll
        for (int t = 0; t < 4; ++t) acc[t] = MFMA32(fa[s & 1], fb[s & 1][t], acc[t]);
        __builtin_amdgcn_sched_barrier(0);
    }
#undef KV_FRAGS
    bf16_t* outp = kvT + ((size_t)((b * 4 + h) * NCH + n)) * 32768;
#pragma unroll
    for (int t = 0; t < 4; ++t)
#pragma unroll
        for (int i = 0; i < 16; ++i) outp[(size_t)(32 * wid + crow(i, hh)) * 128 + t * 32 + r] = (bf16_t)(cvt_pk_bf16(acc[t][i], 0.f) & 0xffffu);
}

__device__ __forceinline__ void scan_phase(const bf16_t* __restrict__ kvT, bf16_t* __restrict__ sprevT, int gtid, int gthreads) {
    for (int it = gtid; it < 16 * 8192; it += gthreads) {
        const int bh = it >> 13, e = (it & 8191) * 4;
        const float gam = __builtin_amdgcn_exp2f(log2gamma(bh & 3) * 128.0f);
        f32x4 run = (f32x4){0.f, 0.f, 0.f, 0.f};
        const bf16_t* kp = kvT + (size_t)bh * NCH * 32768 + e;
        bf16_t* sp = sprevT + (size_t)bh * NCH * 32768 + e;
#pragma unroll 1
        for (int n0 = 0; n0 < NCH - 1; n0 += 8) {
            f32x4 kvv[8];
#pragma unroll
            for (int k = 0; k < 8; ++k) { const u32x2 w_ = *(const u32x2*)(kp + (size_t)(n0 + k) * 32768); kvv[k] = (f32x4){bf_lo(w_.x), bf_hi(w_.x), bf_lo(w_.y), bf_hi(w_.y)}; }
#pragma unroll
            for (int k = 0; k < 8; ++k) {
                u32x2 w; w.x = cvt_pk_bf16(run[0], run[1]); w.y = cvt_pk_bf16(run[2], run[3]);
                *(u32x2*)(sp + (size_t)(n0 + k) * 32768) = w;
                run = run * gam + kvv[k];
            }
        }
        { u32x2 w; w.x = cvt_pk_bf16(run[0], run[1]); w.y = cvt_pk_bf16(run[2], run[3]); *(u32x2*)(sp + (size_t)(NCH - 1) * 32768) = w; }
    }
}

__device__ __forceinline__ void main_unit(LAS unsigned char* lds, const bf16_t* __restrict__ proj, const bf16_t* __restrict__ sprevT, bf16_t* __restrict__ y,
                                          const float* __restrict__ rnorm, int b, int h, int n) {
    int tid = threadIdx.x; asm volatile("" : "+v"(tid));
    const int lane = tid & 63, wid = __builtin_amdgcn_readfirstlane(tid >> 6);
    const int ig = wid & 3, dh = wid >> 2, r = lane & 31, hh = lane >> 5, g16 = (lane >> 4) & 1, q4 = (lane & 15) >> 2, p4 = lane & 3;
    const size_t row0 = (size_t)b * LTOK + (size_t)n * CH;
    const float l2g = log2gamma(h);
    const int iloc = ig * 32 + r;
    __syncthreads();
#pragma unroll
    for (int i = 0; i < 8; ++i) {
        const int j = (tid >> 5) + 16 * i, c = tid & 31;
        const u32x4 vv = *(const u32x4*)(proj + (row0 + j) * DIN + C_RV + h * 256 + c * 8);
        *(LAS u32x4*)(lds + M_V + j * VSTR + c * 16) = vv;
    }
    bf16x8 qf[8];
    { const bf16_t* qp = proj + (row0 + iloc) * DIN + C_RQ + h * 128 + hh * 8;
#pragma unroll
      for (int s = 0; s < 8; ++s) qf[s] = *(const bf16x8*)(qp + s * 16); }
    f32x16 acc[4];
#pragma unroll
    for (int t = 0; t < 4; ++t) acc[t] = zero16();
    { const bf16_t* sp = sprevT + ((size_t)((b * 4 + h) * NCH + n)) * 32768 + (size_t)(dh * 128 + r) * 128 + hh * 8;
      bf16x8 sa[8][4];
#pragma unroll
      for (int s = 0; s < 8; ++s)
#pragma unroll
          for (int t = 0; t < 4; ++t) sa[s][t] = *(const bf16x8*)(sp + (size_t)t * 32 * 128 + s * 16);
#pragma unroll
      for (int s = 0; s < 8; ++s)
#pragma unroll
          for (int t = 0; t < 4; ++t) acc[t] = MFMA32(sa[s][t], qf[s], acc[t]); }
    { const float qd = __builtin_amdgcn_exp2f(l2g * (float)(iloc + 1));
#pragma unroll
      for (int t = 0; t < 4; ++t)
#pragma unroll
          for (int i = 0; i < 16; ++i) acc[t][i] *= qd; }
    __syncthreads();
    const LAS unsigned char* va = lds + M_V + (4 * hh + q4) * VSTR + (dh * 128 + 16 * g16) * 2 + 8 * p4;
    for (int jt = 0; jt <= ig; ++jt) {
        f32x16 st = zero16();
        const bf16_t* kp = proj + (row0 + jt * 32 + r) * DIN + C_RK + h * 128 + hh * 8;
        bf16x8 ka[8];
#pragma unroll
        for (int s = 0; s < 8; ++s) ka[s] = *(const bf16x8*)(kp + s * 16);
#pragma unroll
        for (int s = 0; s < 8; ++s) st = MFMA32(ka[s], qf[s], st);
#pragma unroll
        for (int i = 0; i < 16; ++i) {
            const int d = iloc - (jt * 32 + crow(i, hh));
            const float f = __builtin_amdgcn_exp2f(l2g * (float)d) * 0.08838834764831845f;
            st[i] = d >= 0 ? st[i] * f : 0.f;
        }
#pragma unroll
        for (int s2 = 0; s2 < 2; ++s2) {
            const bf16x8 pb = pack_step(st, s2);
            const LAS unsigned char* vp = va + (jt * 32 + 16 * s2) * VSTR;
#pragma unroll
            for (int t = 0; t < 4; ++t) { const bf16x8 a = cat8(tr_read(vp + t * 64), tr_read(vp + 8 * VSTR + t * 64)); acc[t] = MFMA32(a, pb, acc[t]); }
        }
    }
    float ss = 0.f;
#pragma unroll
    for (int t = 0; t < 4; ++t)
#pragma unroll
        for (int i = 0; i < 16; ++i) ss += acc[t][i] * acc[t][i];
    ss += __shfl_xor(ss, 32);
    LAS float* SS = (LAS float*)(lds + M_SS);
    if (hh == 0) SS[dh * 128 + iloc] = ss;
    __syncthreads();
    const float rstd = __builtin_amdgcn_rsqf((SS[iloc] + SS[128 + iloc]) * (1.0f / 256.0f) + EPS);
    LAS float* T = (LAS float*)(lds + M_T);
#pragma unroll
    for (int t = 0; t < 4; ++t)
#pragma unroll
        for (int gq = 0; gq < 4; ++gq) {
            const f32x4 v = (f32x4){acc[t][4 * gq] * rstd, acc[t][4 * gq + 1] * rstd, acc[t][4 * gq + 2] * rstd, acc[t][4 * gq + 3] * rstd};
            *(LAS f32x4*)(T + iloc * TSTR + dh * 128 + t * 32 + 8 * gq + 4 * hh) = v;
        }
    __syncthreads();
    { const int c = tid & 31;
      const f32x4 w0 = *(const f32x4*)(rnorm + c * 8), w1 = *(const f32x4*)(rnorm + c * 8 + 4);
#pragma unroll
      for (int p = 0; p < 8; ++p) {
          const int row = (tid >> 5) + 16 * p;
          const f32x4 v0 = *(const LAS f32x4*)(T + row * TSTR + c * 8) * w0, v1 = *(const LAS f32x4*)(T + row * TSTR + c * 8 + 4) * w1;
          const u32x4 gg = *(const u32x4*)(proj + (row0 + row) * DIN + C_RG + h * 256 + c * 8);
          float o[8];
#pragma unroll
          for (int k = 0; k < 4; ++k) {
              const float gl = bf_lo(gg[k]), gh = bf_hi(gg[k]);
              const float vl = k < 2 ? v0[2 * k] : v1[2 * k - 4], vh = k < 2 ? v0[2 * k + 1] : v1[2 * k - 3];
              o[2 * k] = vl * gl * __builtin_amdgcn_rcpf(1.0f + __builtin_amdgcn_exp2f(-gl * LOG2E));
              o[2 * k + 1] = vh * gh * __builtin_amdgcn_rcpf(1.0f + __builtin_amdgcn_exp2f(-gh * LOG2E));
          }
          u32x4 w; w.x = cvt_pk_bf16(o[0], o[1]); w.y = cvt_pk_bf16(o[2], o[3]); w.z = cvt_pk_bf16(o[4], o[5]); w.w = cvt_pk_bf16(o[6], o[7]);
          *(u32x4*)(y + (row0 + row) * DM + 1024 + h * 256 + c * 8) = w;
      } }
    __syncthreads();
}
}

__device__ __forceinline__ void transpose_item(const float* __restrict__ W, int K, int N, bf16_t* __restrict__ WT, const float* __restrict__ gain, LAS float* scr, int item, int lane, int mode = 0) {
    const int nblk = N / 32, kb = item / nblk, nb = item % nblk, k0 = 64 * kb, n0 = 32 * nb;
#pragma unroll 8
    for (int i = 0; i < 32; ++i) { const int kk = 2 * i + (lane >> 5); float v = __builtin_nontemporal_load(W + (size_t)(k0 + kk) * N + n0 + (lane & 31)); if (gain) v *= gain[k0 + kk]; scr[kk * 33 + (lane & 31)] = v; }
    asm volatile("s_waitcnt lgkmcnt(0)" ::: "memory");
    const int c = lane & 7;
#pragma unroll
    for (int j = 0; j < 4; ++j) { const int n = (lane >> 3) + 8 * j; const LAS float* s = scr + (8 * c) * 33 + n;
        u32x4 o; o.x = cvt_pk_bf16(s[0 * 33], s[1 * 33]); o.y = cvt_pk_bf16(s[2 * 33], s[3 * 33]); o.z = cvt_pk_bf16(s[4 * 33], s[5 * 33]); o.w = cvt_pk_bf16(s[6 * 33], s[7 * 33]);
        const int nn = n0 + n; const int orow = mode ? ((nn >> 7) * 256 + (nn & 127) + (mode == 2 ? 128 : 0)) : nn;
        __builtin_nontemporal_store(o, (u32x4*)(WT + (size_t)orow * K + k0 + 8 * c)); }
    asm volatile("s_waitcnt lgkmcnt(0)" ::: "memory");
}


struct Args;
__device__ __forceinline__ void convert_layer(const Args& a, unsigned char* ws, LAS unsigned char* lds, int l, int worker, int nworkers, int wave, int lane, int it_lo, int it_hi);
#define XB_TMO      128
#define XB_XCNT(j)  (256  + 64 * (j))
#define XB_XSUB(j)  (1280 + 64 * (j))
#define XB_XGEN(j)  (2304 + 64 * (j))
#define XB_TOP      3328
#define XB_TOPGEN   3392
#define XCD_BAR_WORDS 3456
#define XB_SPIN_CAP (1u << 20)
__device__ __forceinline__ unsigned xb_ld(unsigned* p)              { return __hip_atomic_load(p, __ATOMIC_RELAXED, __HIP_MEMORY_SCOPE_AGENT); }
__device__ __forceinline__ unsigned xb_add(unsigned* p, unsigned v) { return __hip_atomic_fetch_add(p, v, __ATOMIC_RELAXED, __HIP_MEMORY_SCOPE_AGENT); }
__device__ __forceinline__ unsigned xb_xcc_id() { return (unsigned)__builtin_amdgcn_s_getreg((3 << 11) | 20) & 0xFu; }
#define XB_SPIN(cond, bar) do { unsigned _sp = 0; while (cond) { __builtin_amdgcn_s_sleep(1); \
    if ((++_sp & 255u) == 0u) { if (xb_ld(&(bar)[XB_TMO])) break; if (_sp > XB_SPIN_CAP) { atomicAdd(&(bar)[XB_TMO], 1u); break; } } } } while (0)
struct XcdBarrier { unsigned* bar; unsigned x; volatile LAS unsigned* st; };
__device__ __forceinline__ XcdBarrier xcd_barrier_post(unsigned* bar, volatile LAS unsigned* st) {
    XcdBarrier b; b.bar = bar; b.x = xb_xcc_id(); b.st = st;
    if (threadIdx.x == 0) (void)xb_add(&bar[XB_XCNT(b.x)], 1u);
    return b;
}
__device__ __forceinline__ void xcd_barrier_complete(unsigned* bar, unsigned x, unsigned& nloc, unsigned& nx) {
    const unsigned G = gridDim.x * gridDim.y * gridDim.z;
    unsigned sum, cnt, mine, sp = 0u;
    for (;;) {
        sum = 0u; cnt = 0u; mine = 0u;
#pragma unroll
        for (unsigned j = 0; j < 16; ++j) { const unsigned c = xb_ld(&bar[XB_XCNT(j)]); sum += c; cnt += (c > 0u) ? 1u : 0u; mine = (j == x) ? c : mine; }
        if (sum == G) break;
        __builtin_amdgcn_s_sleep(1);
        if ((++sp & 255u) == 0u) { if (xb_ld(&bar[XB_TMO])) break; if (sp > XB_SPIN_CAP) { atomicAdd(&bar[XB_TMO], 1u); break; } }
    }
    nloc = mine > 0u ? mine : 1u; nx = cnt > 0u ? cnt : 1u;
}
__device__ __forceinline__ void xcd_barrier(const XcdBarrier& b) {
    asm volatile("s_waitcnt vmcnt(0)" ::: "memory");
    __syncthreads();
    if (threadIdx.x == 0) {
        unsigned* bar = b.bar;
        __builtin_amdgcn_s_waitcnt(0);
        unsigned nloc = b.st[0], nx = b.st[1];
        if (nloc == 0u) { xcd_barrier_complete(bar, b.x, nloc, nx); b.st[0] = nloc; b.st[1] = nx; }
        const unsigned old = xb_add(&bar[XB_XSUB(b.x)], 1u);
        const unsigned gen = old / nloc;
        if (old + 1u == (gen + 1u) * nloc) {
            __builtin_amdgcn_fence(__ATOMIC_RELEASE, "agent");
            asm volatile("s_waitcnt vmcnt(0)" ::: "memory");
            const unsigned og = xb_add(&bar[XB_TOP], 1u);
            const unsigned tg = og / nx;
            if (og + 1u == (tg + 1u) * nx) xb_add(&bar[XB_TOPGEN], 1u);
            else XB_SPIN(xb_ld(&bar[XB_TOPGEN]) == tg, bar);
            __builtin_amdgcn_fence(__ATOMIC_ACQUIRE, "agent");
            xb_add(&bar[XB_XGEN(b.x)], 1u);
            asm volatile("s_waitcnt vmcnt(0)" ::: "memory");
        } else {
            XB_SPIN(xb_ld(&bar[XB_XGEN(b.x)]) == gen, bar);
            __builtin_amdgcn_fence(__ATOMIC_ACQUIRE, "agent");
            asm volatile("s_waitcnt vmcnt(0)" ::: "memory");
        }
    }
    __syncthreads();
}

struct Args {
    const float* x; const float* meta; const float* attn_norm; const float* w_in; const float* lambda_qk; const float* attn_subln; const float* ret_norm;
    const float* w_out; const float* ffn_norm; const float* w_gate; const float* w_up; const float* conv_w; const float* w_down; const float* final_norm;
    float* out; unsigned char* ws;
};


__device__ __forceinline__ void convert_layer(const Args& a, unsigned char* ws, LAS unsigned char* lds, int l, int worker, int nworkers, int wave, int lane, int it_lo, int it_hi) {
    LAS float* scr = (LAS float*)(lds + wave * 16384);
    constexpr int I_IN = 32 * 192, I_OUT = 32 * 64, I_G = 32 * 176, I_D = 88 * 64, I_LAYER = I_IN + I_OUT + 2 * I_G + I_D;
    unsigned char* wl = ws + WS_WT + (size_t)l * WT_LAYER;
    for (int it = it_lo + worker; it < it_hi; it += nworkers) {
        int rr = it;
        if (rr < I_IN) { transpose_item(a.w_in + (size_t)l * DM * DIN, DM, DIN, (bf16_t*)(wl + WT_IN), a.attn_norm + l * DM, scr, rr, lane); continue; } rr -= I_IN;
        if (rr < I_OUT) { transpose_item(a.w_out + (size_t)l * DM * DM, DM, DM, (bf16_t*)(wl + WT_OUT), nullptr, scr, rr, lane); continue; } rr -= I_OUT;
        if (rr < I_G) { transpose_item(a.w_gate + (size_t)l * DM * DFF, DM, DFF, (bf16_t*)(wl + WT_GATE), a.ffn_norm + l * DM, scr, rr, lane, 1); continue; } rr -= I_G;
        if (rr < I_G) { transpose_item(a.w_up + (size_t)l * DM * DFF, DM, DFF, (bf16_t*)(wl + WT_GATE), a.ffn_norm + l * DM, scr, rr, lane, 2); continue; } rr -= I_G;
        transpose_item(a.w_down + (size_t)l * DFF * DM, DFF, DM, (bf16_t*)(wl + WT_DOWN), nullptr, scr, rr, lane);
    }
}

__global__ void __launch_bounds__(512, 2) hymba_fwd(Args a) {
    extern __shared__ __attribute__((aligned(16))) unsigned char lds_raw[];
    LAS unsigned char* lds = (LAS unsigned char*)lds_raw;
    cg::grid_group grid = cg::this_grid();
#define FRESH_TID() int tid = threadIdx.x; asm volatile("" : "+v"(tid)); const int lane = tid & 63, wave = __builtin_amdgcn_readfirstlane(tid >> 6); (void)lane; (void)wave
    const int G = gridDim.x, bx = blockIdx.x;
    unsigned char* ws = a.ws;
    unsigned* ctl = (unsigned*)(ws + WS_CTL);
    float* ssqA = (float*)(ws + WS_SSQ);
    float* ssqF = ssqA + (size_t)MT * 32;
    bf16_t* hlo = (bf16_t*)(ws + WS_H);
    bf16_t* hb = (bf16_t*)(ws + WS_H + (size_t)MT * DM * 2);
    bf16_t* sprevT = (bf16_t*)((unsigned char*)a.out + OUT_SPREV);
    bf16_t* proj = (bf16_t*)(ws + WS_R + R_PROJ);
    bf16_t* ybuf = (bf16_t*)(ws + WS_R + R_Y);
    bf16_t* kvT = (bf16_t*)(ws + WS_R + R_KV);
    bf16_t* gbuf = (bf16_t*)(ws + WS_R + R_G);
    bf16_t* actbuf = (bf16_t*)(ws + WS_R + R_ACT);

    if (threadIdx.x < 64) ((LAS unsigned*)(lds + LDS_MISC))[threadIdx.x] = 0u;
    __syncthreads();
    if (threadIdx.x == 0) { ((LAS unsigned long long*)(lds + LDS_MISC + 64))[0] = (unsigned long long)a.x; ((LAS unsigned long long*)(lds + LDS_MISC + 64))[1] = (unsigned long long)a.meta; }
    for (int rep = 0; rep < REP_PRO; ++rep) {
        FRESH_TID();
        const int gtid = bx * 512 + tid, gth = G * 512;
        for (int i = gtid; i < 8192; i += gth) ctl[i] = 0u;
        const int gw = bx * 8 + wave, NGW = G * 8;
        for (int row = gw; row < MT; row += NGW) {
            const int bb = row / LTOK, t = row % LTOK;
            f32x4 v[8]; float s = 0.f;
            if (t < PADF) {
#pragma unroll
                for (int j = 0; j < 8; ++j) v[j] = (f32x4){0.f, 0.f, 0.f, 0.f};
            } else {
                const float* src = t < CH ? a.meta + (size_t)(t - PADF) * DM : a.x + ((size_t)bb * SEQ + (t - CH)) * DM;
#pragma unroll
                for (int j = 0; j < 8; ++j) { v[j] = *((const f32x4*)src + 64 * j + lane); s += (v[j][0] * v[j][0] + v[j][1] * v[j][1]) + (v[j][2] * v[j][2] + v[j][3] * v[j][3]); }
            }
            s = wave_sum(s);
            if (lane < 32) ssqA[(size_t)row * 32 + lane] = lane == 0 ? s : 0.f;
#pragma unroll
            for (int j = 0; j < 8; ++j) {
                u32x2 w; w.x = cvt_pk_bf16(v[j][0], v[j][1]); w.y = cvt_pk_bf16(v[j][2], v[j][3]);
                *((u32x2*)(hb + (size_t)row * DM) + 64 * j + lane) = w;
            }
        }
        convert_layer(a, ws, lds, 0, gw, NGW, wave, lane, 0, CV_IN);
        convert_layer(a, ws, lds, 0, gw, NGW, wave, lane, CV_GATE, CV_ALL);
    }
    grid.sync();
    const XcdBarrier xbar = xcd_barrier_post(ctl + 4096, (volatile LAS unsigned*)(lds + LDS_MISC + 32));
#define GSYNC() xcd_barrier(xbar)

#pragma unroll 1
    for (int l = 0; l < DEPTH; ++l) {
        unsigned char* wl = ws + WS_WT + (size_t)l * WT_LAYER;
        for (int rep = 0; rep < REP_INP; ++rep) {
            pg8::Gemm g{hb, (const bf16_t*)(wl + WT_IN), MT, DIN, DM, DM}; pg8::StaticOrder S; S.init(MT, DIN, G, bx);
            pg8::EpiScaleBf16 E{proj, DIN, ssqA};
            pg8::gemm_phase<pg8::EpiScaleBf16, pg8::StaticOrder, true, true>(lds, g, S, E);
            if (l == 0 && bx >= 48) { FRESH_TID(); convert_layer(a, ws, lds, 0, (bx - 48) * 8 + wave, (G - 48) * 8, wave, lane, CV_IN, CV_GATE); }
        }
        GSYNC();
        for (int rep = 0; rep < REP_MIX; ++rep) {
        for (int rk = 0; rk < REP_KV; ++rk) {
        for (int u = bx; u < 16 * 32; u += G) ret::kv_unit(lds, proj, kvT, u >> 7, (u >> 5) & 3, u & 31);
        for (int u = bx; u < 256; u += G) att::kmax_unit(proj, ctl + 1536 + l * 64, u);
        GSYNC();
        { FRESH_TID(); ret::scan_phase(kvT, sprevT, bx * 512 + tid, G * 512); }
        GSYNC();
        }
        {
            FRESH_TID();
            float lam;
            { const float* lq = a.lambda_qk + l * 256;
              const float s1 = wave_sum(lq[lane] * lq[64 + lane]), s2 = wave_sum(lq[128 + lane] * lq[192 + lane]);
              const float lam_init = 0.8f - 0.6f * __expf(-0.3f * (float)l);
              lam = __expf(s1) - __expf(s2) + lam_init; }
            const float lam_init = 0.8f - 0.6f * __expf(-0.3f * (float)l);
            LAS volatile int* slot = (LAS volatile int*)(lds + LDS_MISC);
            for (int pass = 0; pass < 1 + XREP_ATT + XREP_RET; ++pass) {
                const int ulo = (pass > XREP_ATT) ? 1056 : 0, uhi = (pass >= 1 && pass <= XREP_ATT) ? 1056 : 1584;
                for (;;) {
                    if (tid == 0) *slot = ulo + (int)atomicAdd(ctl + 16 * l + 4 * rep + pass, 1u);
                    __syncthreads();
                    const int u = *slot;
                    if (u >= uhi) break;
                    if (u < 256 || u >= 256 + 528) { const int w = u < 256 ? u : u - 528; att::attn_unit(lds, proj, ybuf, w & 3, (w >> 2) & 7, 32 - (w >> 5), lam, a.attn_subln + l * 128, 1.0f - lam_init, ctl + 1536 + l * 64); }
                    else { const int v = u - 256; ret::main_unit(lds, proj, sprevT, ybuf, a.ret_norm + l * 256, v & 3, (v >> 2) & 3, v >> 4); }
                }
                __syncthreads();
            }
        }
        GSYNC();
        }
        {
            pg8::Gemm g{ybuf, (const bf16_t*)(wl + WT_OUT), MT, DM, DM, DM}; pg8::StaticOrder S; S.init(MT, DM, G, bx); S.limit = 2 * 256;
            pg8::Gemm gt{ybuf, (const bf16_t*)(wl + WT_OUT), MT, DM, 512, DM}; const pg8::TailOrder T{MT / 256, DM / 256, 2 * 256, 16, bx};
            float* const part = (float*)(ws + WS_R + R_PROJ);
            { pg8::EpiResidual<false> E{hlo, hb, ssqF, 1.f}; pg8::gemm_phase<pg8::EpiResidual<false>, pg8::StaticOrder, true, true>(lds, g, S, E);
                pg8::EpiSplitK<pg8::EpiResidual<false>> Et{E, part, ctl + 2048 + l * 256 + 64}; pg8::gemm_phase<pg8::EpiSplitK<pg8::EpiResidual<false>>, pg8::TailOrder, true, true>(lds, gt, T, Et); }
        }
        GSYNC();
        {
            pg8::Gemm g{hb, (const bf16_t*)(wl + WT_GATE), 67 * 256, 2 * DFF, DM, DM}; pg8::StaticOrder S; S.init(67 * 256, 2 * DFF, G, bx);
            pg8::EpiGateUp E{actbuf, a.conv_w + (size_t)l * 3 * DFF, ssqF};
            pg8::gemm_phase<pg8::EpiGateUp, pg8::StaticOrder, true, true>(lds, g, S, E);
        }
        GSYNC();
        for (int xs = 0; xs < XSYNC; ++xs) GSYNC();
        {
            pg8::Gemm g{actbuf, (const bf16_t*)(wl + WT_DOWN), MT, DM, DFF, DFF}; pg8::StaticOrder S; S.init(MT, DM, G, bx);
            pg8::EpiResidual<false> E{hlo, hb, ssqA, 1.f};
            if (l + 1 < DEPTH) {
                pg8::gemm_phase<pg8::EpiResidual<false>, pg8::StaticOrder, true, true>(lds, g, S, E);
                if (bx >= 16) { FRESH_TID(); convert_layer(a, ws, lds, l + 1, (bx - 16) * 8 + wave, (G - 16) * 8, wave, lane, 0, CV_ALL); }
            } else {
                S.limit = 2 * 256;
                pg8::gemm_phase<pg8::EpiResidual<false>, pg8::StaticOrder, true, true>(lds, g, S, E);
                pg8::Gemm gt{actbuf, (const bf16_t*)(wl + WT_DOWN), MT, DM, DFF / 4, DFF}; const pg8::TailOrder T{MT / 256, DM / 256, 2 * 256, 16, bx};
                pg8::EpiSplitK<pg8::EpiResidual<false>> Et{E, (float*)(ws + WS_R + R_G), ctl + 2048 + l * 256 + 128};
                pg8::gemm_phase<pg8::EpiSplitK<pg8::EpiResidual<false>>, pg8::TailOrder, true, true>(lds, gt, T, Et);
            }
        }
        GSYNC();
    }
    {
        FRESH_TID();
        const int gw = bx * 8 + wave, NGW = G * 8;
        f32x4 wv[8];
#pragma unroll
        for (int j = 0; j < 8; ++j) wv[j] = *((const f32x4*)a.final_norm + 64 * j + lane);
        for (int orow = gw; orow < NB * SEQ; orow += NGW) {
            const int bb = orow / SEQ, s = orow % SEQ; const int row = bb * LTOK + CH + s;
            const float rstd = row_rstd(ssqA, row);
#pragma unroll
            for (int j = 0; j < 8; ++j) {
                const u32x2 hi = *((const u32x2*)(hb + (size_t)row * DM) + 64 * j + lane);
                const f32x4 v = (f32x4){bf_lo(hi.x), bf_hi(hi.x), bf_lo(hi.y), bf_hi(hi.y)};
                __builtin_nontemporal_store(v * rstd * wv[j], (f32x4*)(a.out + (size_t)orow * DM) + 64 * j + lane); }
        }
    }
}

extern "C" void kernel_launch(void* const* d_in, const int* in_sizes, int n_in, void* d_out, int out_size, void* d_ws, size_t ws_size, hipStream_t stream) {
    static int grid = 0;
    if (grid == 0) {
        if (n_in != 14 || ws_size < WS_END || out_size != NB * SEQ * DM) { fprintf(stderr, "kernel_launch: unexpected problem shape (n_in %d, ws %zu need %zu, out %d)\n", n_in, ws_size, (size_t)WS_END, out_size); grid = -1; return; }
        int dev = 0, cus = 0, per_cu = 0;
        hipGetDevice(&dev);
        hipDeviceGetAttribute(&cus, hipDeviceAttributeMultiprocessorCount, dev);
        hipFuncSetAttribute((const void*)hymba_fwd, hipFuncAttributeMaxDynamicSharedMemorySize, LDS_BYTES);
        hipOccupancyMaxActiveBlocksPerMultiprocessor(&per_cu, (const void*)hymba_fwd, 512, LDS_BYTES);
        (void)hipGetLastError();
        if (per_cu < 1) per_cu = 1;
        grid = cus * 1;
    }
    if (grid < 0) return;
    Args a{};
    a.x = (const float*)d_in[0]; a.meta = (const float*)d_in[1]; a.attn_norm = (const float*)d_in[2]; a.w_in = (const float*)d_in[3];
    a.lambda_qk = (const float*)d_in[4]; a.attn_subln = (const float*)d_in[5]; a.ret_norm = (const float*)d_in[6]; a.w_out = (const float*)d_in[7];
    a.ffn_norm = (const float*)d_in[8]; a.w_gate = (const float*)d_in[9]; a.w_up = (const float*)d_in[10]; a.conv_w = (const float*)d_in[11];
    a.w_down = (const float*)d_in[12]; a.final_norm = (const float*)d_in[13];
    a.out = (float*)d_out; a.ws = (unsigned char*)d_ws;
    void* args[] = {&a};
    hipError_t e = hipLaunchCooperativeKernel((const void*)hymba_fwd, dim3(grid), dim3(512), args, LDS_BYTES, stream);
    if (e != hipSuccess) fprintf(stderr, "cooperative launch failed: %s (grid %d)\n", hipGetErrorString(e), grid);
}
```

```cpp
#include <hip/hip_runtime.h>
#include <hip/hip_cooperative_groups.h>
#include <cstdio>
#include <cstdint>
namespace cg = cooperative_groups;

#define LAS __attribute__((address_space(3)))
typedef unsigned short bf16_t;
typedef short bf16x8 __attribute__((ext_vector_type(8)));
typedef short s16x4 __attribute__((ext_vector_type(4)));
typedef float f32x4 __attribute__((ext_vector_type(4)));
typedef float f32x2 __attribute__((ext_vector_type(2)));
typedef float f32x16 __attribute__((ext_vector_type(16)));
typedef unsigned u32x4 __attribute__((ext_vector_type(4)));
typedef unsigned u32x2 __attribute__((ext_vector_type(2)));

constexpr int DM = 2048, NB = 4, SEQ = 4096, DEPTH = 4, LTOK = 4224, PADF = 112, CH = 128, NCH = 33;
constexpr int MT = NB * LTOK;
constexpr int DIN = 6144, DFF = 5632;
constexpr int C_AQ = 0, C_AK = 1024, C_AV = 2048, C_RQ = 3072, C_RK = 3584, C_RV = 4096, C_RG = 5120;
constexpr float EPS = 1e-6f;
constexpr float LOG2E = 1.4426950408889634f;

constexpr size_t WS_CTL = 0, CTL_BYTES = 1u << 20;
constexpr size_t CTL_SSQ_OFF = 4096;
constexpr size_t WT_IN = 0, WT_OUT = 25165824, WT_GATE = 33554432, WT_UP = 56623104, WT_DOWN = 79691776, WT_LAYER = 102760448;
constexpr size_t WS_WT = CTL_BYTES;
constexpr size_t WS_H = WS_WT + 4 * WT_LAYER;
constexpr size_t WS_R = WS_H + (size_t)MT * DM * 4;
constexpr size_t R_PROJ = 0, R_Y = (size_t)MT * DIN * 2, R_KV = R_Y + (size_t)MT * DM * 2;
constexpr size_t R_G = 0, R_ACT = (size_t)MT * DFF * 2;
constexpr size_t WS_SSQ = WS_R + 2 * (size_t)MT * DFF * 2;
constexpr size_t WS_END = WS_SSQ + 2 * (size_t)MT * 32 * 4;
constexpr size_t OUT_HB = 0, OUT_SPREV = (size_t)MT * DM * 2;

constexpr int REP_PRO = 1, REP_INP = 1, REP_MIX = 1, REP_GATE = 1, REP_UP = 1, REP_KV = 1, XREP_ATT = 0, XREP_RET = 0, XSYNC = 0, XREP_OUT = 0, XREP_DOWN = 0;
constexpr int CV_IN = 32 * 192, CV_OUT = CV_IN + 32 * 64, CV_GATE = CV_OUT + 32 * 176, CV_UP = CV_GATE + 32 * 176, CV_ALL = CV_UP + 88 * 64;
constexpr int LDS_BYTES = 147456;
constexpr int LDS_MISC = 144384;

__device__ __forceinline__ unsigned cvt_pk_bf16(float lo, float hi) { unsigned r; asm volatile("v_cvt_pk_bf16_f32 %0, %1, %2" : "=v"(r) : "v"(lo), "v"(hi)); return r; }
__device__ __forceinline__ float bf_lo(unsigned w) { return __uint_as_float(w << 16); }
__device__ __forceinline__ float bf_hi(unsigned w) { return __uint_as_float(w & 0xffff0000u); }
__device__ __forceinline__ bool is_pad_row(int row) { return (row % LTOK) < PADF; }
__device__ __forceinline__ float row_rstd(const float* part, int row) {
    const f32x4* p = (const f32x4*)(part + (size_t)row * 32);
    float s = 0.f;
#pragma unroll
    for (int k = 0; k < 8; ++k) { const f32x4 v = p[k]; s += (v[0] + v[1]) + (v[2] + v[3]); }
    return __builtin_amdgcn_rsqf(s * (1.0f / 2048.0f) + 1e-6f);
}
__device__ __forceinline__ float wave_sum(float v) {
#pragma unroll
    for (int o = 1; o < 64; o <<= 1) v += __shfl_xor(v, o);
    return v;
}

namespace pg8 {
#define PG8_LAS __attribute__((address_space(3)))
constexpr int BM = 256, BK = 64, HALF = 128, HTB = HALF * BK * 2, STAGE_BYTES = 8 * HTB, NXCD = 8, WGM = 8;
__host__ __device__ __forceinline__ int lds_byte(int r, int c) { const int st = (r >> 4) * 2 + (c >> 5), rr = r & 15, cc = c & 31, ob = rr * 64 + cc * 2; return st * 1024 + (ob ^ (((ob >> 9) & 1) << 5)); }
__host__ __device__ __forceinline__ void stage_rc(int b, int& R, int& C) { const int st = b / 1024, sb = b % 1024, swz = sb ^ (((sb >> 9) & 1) << 5); R = (st >> 1) * 16 + swz / 64; C = (st & 1) * 32 + (swz % 64) / 2; }
__host__ __device__ __forceinline__ int perm32(int rho) { const int n = rho >> 4, i = rho & 15; return 8 * (i >> 2) + 4 * n + (i & 3); }
struct Unit { int pm, pn, ks; };
struct Gemm { const bf16_t* A; const bf16_t* Bt; int M, N, K, ld; };
__host__ __device__ __forceinline__ void tile_of(int wgid, int nM, int nN, int& pm, int& pn) {
    const int nwg = nM * nN;
    { const int q = nwg / NXCD, r = nwg % NXCD, xcd = wgid % NXCD, off = wgid / NXCD; wgid = (xcd < r ? xcd * (q + 1) : r * (q + 1) + (xcd - r) * q) + off; }
    const int nig = WGM * nN, gid = wgid / nig, fm = gid * WGM, gsz = (nM - fm) < WGM ? (nM - fm) : WGM;
    pm = fm + ((wgid % nig) % gsz); pn = (wgid % nig) / gsz;
}
struct StaticOrder {
    int nM, nN, nwg, G, c, limit;
    __host__ __device__ void init(int M, int N, int G_, int c_) { nM = M / BM; nN = N / BM; nwg = nM * nN; G = G_; c = c_; limit = nwg; }
    __host__ __device__ bool next(int i, Unit& u) const {
        const long L = (long)i * G + c; if (L >= limit) return false;
        tile_of((int)L, nM, nN, u.pm, u.pn); u.ks = 0; return true;
    }
    __device__ __forceinline__ void a_ready(const Unit&) const {}
    __device__ __forceinline__ void done(const Unit&) const {}
};
struct TailOrder {
    int nM, nN, first, ntiles, c;
    __host__ __device__ bool next(int i, Unit& u) const {
        if (i != 0 || c >= 4 * ntiles) return false;
        tile_of(first + (c >> 2), nM, nN, u.pm, u.pn); u.ks = c & 3; return true;
    }
    __device__ __forceinline__ void a_ready(const Unit&) const {}
    __device__ __forceinline__ void done(const Unit&) const {}
};

__device__ __forceinline__ void rstd_table(PG8_LAS unsigned char* lds, const float* part, int pm, int tid) {
    PG8_LAS float* RS = (PG8_LAS float*)(lds + 131072);
    const int rl = tid >> 1, row = pm * BM + rl;
    const f32x4* p = (const f32x4*)(part + (size_t)row * 32 + (tid & 1) * 16);
    const f32x4 v0 = p[0], v1 = p[1], v2 = p[2], v3 = p[3];
    float s = (((v0[0] + v0[1]) + (v0[2] + v0[3])) + ((v1[0] + v1[1]) + (v1[2] + v1[3]))) + (((v2[0] + v2[1]) + (v2[2] + v2[3])) + ((v3[0] + v3[1]) + (v3[2] + v3[3])));
    const float o = __shfl_xor(s, 1);
    s = (tid & 1) ? o + s : s + o;
    if ((tid & 1) == 0) RS[rl] = is_pad_row(row) ? 0.f : __builtin_amdgcn_rsqf(s * (1.0f / 2048.0f) + 1e-6f);
    asm volatile("s_waitcnt lgkmcnt(0)" ::: "memory"); __builtin_amdgcn_s_barrier(); asm volatile("" ::: "memory");
}
struct EpiScaleBf16 {
    static constexpr bool PERM = true, AFTER_DRAIN = false, OVERLAP = false;
    bf16_t* O; int ldc; const float* ssq;
    __device__ __forceinline__ void operator()(const f32x4 (&acc)[2][2][4][2], const Unit& u, int wr, int wc, int fr, int fq, PG8_LAS unsigned char* lds, int tid, int quad = -1) const {
        rstd_table(lds, ssq, u.pm, tid);
        const PG8_LAS float* RS = (const PG8_LAS float*)(lds + 131072);
        const int rl0 = wr * 64 + fr; const int col0 = u.pn * BM + wc * 32 + 8 * fq;
#pragma unroll
        for (int ai = 0; ai < 2; ++ai)
#pragma unroll
            for (int m = 0; m < 4; ++m) {
                if (quad >= 0 && ai * 2 + (m >> 1) != quad) continue;
                const int rl = rl0 + ai * HALF + m * 16;
                const float sc = RS[rl];
                bf16_t* rowp = O + (size_t)(u.pm * BM + rl) * ldc + col0;
#pragma unroll
                for (int bj = 0; bj < 2; ++bj) { const f32x4 v0 = acc[ai][bj][m][0] * sc, v1 = acc[ai][bj][m][1] * sc;
                    u32x4 w; w.x = cvt_pk_bf16(v0[0], v0[1]); w.y = cvt_pk_bf16(v0[2], v0[3]); w.z = cvt_pk_bf16(v1[0], v1[1]); w.w = cvt_pk_bf16(v1[2], v1[3]);
                    *(u32x4*)(rowp + bj * HALF) = w; }
            }
    }
};
template <bool FIRST> struct EpiResidual {
    static constexpr bool PERM = true, AFTER_DRAIN = false, OVERLAP = false;
    bf16_t* hlo; bf16_t* hb; float* ssq_next; float scale;
    __device__ __forceinline__ void operator()(const f32x4 (&acc)[2][2][4][2], const Unit& u, int wr, int wc, int fr, int fq, PG8_LAS unsigned char* lds, int tid, int quad = -1) const {
        const int row0 = u.pm * BM + wr * 64 + fr; const int col0 = u.pn * BM + wc * 32 + 8 * fq;
        const int b0_ = row0 / LTOK, t0_ = row0 % LTOK; (void)b0_; (void)t0_;
        const float* x0 = nullptr; const float* meta0 = nullptr;
        if constexpr (FIRST) { x0 = (const float*)(*(const PG8_LAS unsigned long long*)(lds + 144384 + 64)); meta0 = (const float*)(*(const PG8_LAS unsigned long long*)(lds + 144384 + 72)); }
        f32x4 pre[2][2][2];
#define E2_LOAD(p, buf) do { const int row_ = row0 + ((p) >> 2) * HALF + ((p) & 3) * 16; \
            if constexpr (FIRST) { int t_ = t0_ + ((p) >> 2) * HALF + ((p) & 3) * 16, bb_ = b0_; if (t_ >= LTOK) { t_ -= LTOK; bb_ += 1; } \
                const float* src_ = t_ < CH ? meta0 + (size_t)(t_ < PADF ? 0 : t_ - PADF) * DM : x0 + ((size_t)bb_ * SEQ + (t_ - CH)) * DM; \
                _Pragma("unroll") for (int bj_ = 0; bj_ < 2; ++bj_) _Pragma("unroll") for (int n_ = 0; n_ < 2; ++n_) pre[buf][bj_][n_] = *(const f32x4*)(src_ + col0 + bj_ * HALF + n_ * 4); } \
            else { _Pragma("unroll") for (int bj_ = 0; bj_ < 2; ++bj_) { const size_t off_ = (size_t)row_ * DM + col0 + bj_ * HALF; \
                pre[buf][bj_][0] = __builtin_bit_cast(f32x4, *(const u32x4*)(hb + off_)); } } } while (0)
        if (quad < 0) E2_LOAD(0, 0);
#pragma unroll
        for (int p = 0; p < 8; ++p) {
            if (quad >= 0) { if ((p >> 1) != quad) continue; E2_LOAD(p, p & 1); }
            else if (p + 1 < 8) E2_LOAD(p + 1, (p + 1) & 1);
            asm volatile("" ::: "memory");
            const int ai = p >> 2, m = p & 3;
            {
                const int row = row0 + ai * HALF + m * 16; const bool pad = is_pad_row(row);
                float ss = 0.f;
#pragma unroll
                for (int bj = 0; bj < 2; ++bj) {
                    const size_t off = (size_t)row * DM + col0 + bj * HALF;
                    f32x4 r0, r1;
                    if constexpr (FIRST) { r0 = pre[p & 1][bj][0]; r1 = pre[p & 1][bj][1]; }
                    else { const u32x4 hi = __builtin_bit_cast(u32x4, pre[p & 1][bj][0]);
                        r0 = (f32x4){bf_lo(hi[0]), bf_hi(hi[0]), bf_lo(hi[1]), bf_hi(hi[1])};
                        r1 = (f32x4){bf_lo(hi[2]), bf_hi(hi[2]), bf_lo(hi[3]), bf_hi(hi[3])}; }
                    f32x4 v0 = r0 + acc[ai][bj][m][0] * scale, v1 = r1 + acc[ai][bj][m][1] * scale;
                    if (pad) { v0 = (f32x4){0.f, 0.f, 0.f, 0.f}; v1 = v0; }
                    u32x4 w; w.x = cvt_pk_bf16(v0[0], v0[1]); w.y = cvt_pk_bf16(v0[2], v0[3]); w.z = cvt_pk_bf16(v1[0], v1[1]); w.w = cvt_pk_bf16(v1[2], v1[3]);
                    *(u32x4*)(hb + off) = w;
                    ss += ((v0[0] * v0[0] + v0[1] * v0[1]) + (v0[2] * v0[2] + v0[3] * v0[3])) + ((v1[0] * v1[0] + v1[1] * v1[1]) + (v1[2] * v1[2] + v1[3] * v1[3]));
                }
                ss += __shfl_xor(ss, 16); ss += __shfl_xor(ss, 32);
                if (fq == 0) ssq_next[(size_t)row * 32 + u.pn * 4 + wc] = ss;
            }
            asm volatile("" ::: "memory");
        }
#undef E2_LOAD
    }
};
struct EpiUpConv {
    static constexpr bool PERM = true, AFTER_DRAIN = false, OVERLAP = false;
    const bf16_t* g; bf16_t* act; const float* cw; const float* ssq;
    __device__ __forceinline__ void operator()(const f32x4 (&acc)[2][2][4][2], const Unit& u, int wr, int wc, int fr, int fq, PG8_LAS unsigned char* lds, int tid) const {
        const int rl0 = wr * 64 + fr; const int col0 = u.pn * BM + wc * 32 + 8 * fq;
        u32x4 gq[2][3];
#define E4_LOAD(p, buf) do { const int col_ = col0 + ((p) >> 3) * HALF; \
            const int row_ = u.pm * BM + rl0 + (((p) >> 2) & 1) * HALF + ((p) & 3) * 16; const int r1_ = row_ > 0 ? row_ - 1 : 0, r2_ = row_ > 1 ? row_ - 2 : 0; \
            gq[buf][0] = *(const u32x4*)(g + (size_t)row_ * DFF + col_); gq[buf][1] = *(const u32x4*)(g + (size_t)r1_ * DFF + col_); gq[buf][2] = *(const u32x4*)(g + (size_t)r2_ * DFF + col_); } while (0)
        E4_LOAD(0, 0);
        rstd_table(lds, ssq, u.pm, tid);
        const PG8_LAS float* RS = (const PG8_LAS float*)(lds + 131072);
        float c0[8], c1[8], c2[8];
#pragma unroll
        for (int p = 0; p < 16; ++p) {
            const int bj = p >> 3, ai = (p >> 2) & 1, m = p & 3;
            const int col = col0 + bj * HALF;
            if ((p & 7) == 0) {
                const f32x4 a0 = *(const f32x4*)(cw + col), a1 = *(const f32x4*)(cw + col + 4);
                const f32x4 b0 = *(const f32x4*)(cw + DFF + col), b1 = *(const f32x4*)(cw + DFF + col + 4);
                const f32x4 d0 = *(const f32x4*)(cw + 2 * DFF + col), d1 = *(const f32x4*)(cw + 2 * DFF + col + 4);
#pragma unroll
                for (int k = 0; k < 4; ++k) { c0[k] = a0[k]; c0[4 + k] = a1[k]; c1[k] = b0[k]; c1[4 + k] = b1[k]; c2[k] = d0[k]; c2[4 + k] = d1[k]; }
            }
            if (p + 1 < 16) E4_LOAD(p + 1, (p + 1) & 1);
            asm volatile("" ::: "memory");
            {
                const int rl = rl0 + ai * HALF + m * 16;
                const float sc = RS[rl];
                const u32x4 g0 = gq[p & 1][0], g1 = gq[p & 1][1], g2 = gq[p & 1][2];
                float o[8];
#pragma unroll
                for (int k = 0; k < 4; ++k) {
                    const float x0l = bf_lo(g0[k]), x0h = bf_hi(g0[k]), x1l = bf_lo(g1[k]), x1h = bf_hi(g1[k]), x2l = bf_lo(g2[k]), x2h = bf_hi(g2[k]);
                    const float gl = c0[2 * k] * x2l + c1[2 * k] * x1l + c2[2 * k] * x0l;
                    const float gh = c0[2 * k + 1] * x2h + c1[2 * k + 1] * x1h + c2[2 * k + 1] * x0h;
                    const float upl = (k < 2 ? acc[ai][bj][m][0][2 * k] : acc[ai][bj][m][1][2 * k - 4]) * sc;
                    const float uph = (k < 2 ? acc[ai][bj][m][0][2 * k + 1] : acc[ai][bj][m][1][2 * k - 3]) * sc;
                    o[2 * k] = gl * __builtin_amdgcn_rcpf(1.0f + __builtin_amdgcn_exp2f(-gl * LOG2E)) * upl;
                    o[2 * k + 1] = gh * __builtin_amdgcn_rcpf(1.0f + __builtin_amdgcn_exp2f(-gh * LOG2E)) * uph;
                }
                u32x4 w; w.x = cvt_pk_bf16(o[0], o[1]); w.y = cvt_pk_bf16(o[2], o[3]); w.z = cvt_pk_bf16(o[4], o[5]); w.w = cvt_pk_bf16(o[6], o[7]);
                *(u32x4*)(act + (size_t)(u.pm * BM + rl) * DFF + col) = w;
            }
            asm volatile("" ::: "memory");
        }
#undef E4_LOAD
    }
};

struct EpiGateUp {
    static constexpr bool PERM = true, AFTER_DRAIN = false, OVERLAP = true;
    bf16_t* act; const float* cw; const float* ssq;
    __device__ __forceinline__ void operator()(const f32x4 (&acc)[2][2][4][2], const Unit& u, int wr, int wc, int fr_in, int fq_in, PG8_LAS unsigned char* lds, int tid_in, int quad = -1) const {
        int fr = fr_in, fq = fq_in, tid = tid_in; asm volatile("" : "+v"(fr), "+v"(fq), "+v"(tid));
        const int rb = u.pm * 254 - 2 > 0 ? u.pm * 254 - 2 : 0;
        const int cl = wc * 32 + 8 * fq;
        PG8_LAS unsigned char* HB = lds + 131072 + 4096;
        if (fr >= 14) {
#pragma unroll
            for (int ai = 0; ai < 2; ++ai)
#pragma unroll
                for (int m = 0; m < 4; ++m) { const f32x4 v0 = acc[ai][0][m][0], v1 = acc[ai][0][m][1];
                    u32x4 w; w.x = cvt_pk_bf16(v0[0], v0[1]); w.y = cvt_pk_bf16(v0[2], v0[3]); w.z = cvt_pk_bf16(v1[0], v1[1]); w.w = cvt_pk_bf16(v1[2], v1[3]);
                    *(PG8_LAS u32x4*)(HB + (((ai * 8 + wr * 4 + m) * 2 + (fr - 14)) * 128 + cl) * 2) = w; }
        }
        {
            PG8_LAS float* RSw = (PG8_LAS float*)(lds + 131072);
            const int rl_ = tid >> 1, row_ = rb + rl_;
            const f32x4* p = (const f32x4*)(ssq + (size_t)row_ * 32 + (tid & 1) * 16);
            const f32x4 v0 = p[0], v1 = p[1], v2 = p[2], v3 = p[3];
            float s = (((v0[0] + v0[1]) + (v0[2] + v0[3])) + ((v1[0] + v1[1]) + (v1[2] + v1[3]))) + (((v2[0] + v2[1]) + (v2[2] + v2[3])) + ((v3[0] + v3[1]) + (v3[2] + v3[3])));
            const float o = __shfl_xor(s, 1);
            s = (tid & 1) ? o + s : s + o;
            if ((tid & 1) == 0) RSw[rl_] = (is_pad_row(row_) || row_ >= MT) ? 0.f : __builtin_amdgcn_rsqf(s * (1.0f / 2048.0f) + 1e-6f);
            asm volatile("s_waitcnt lgkmcnt(0)" ::: "memory"); __builtin_amdgcn_s_barrier(); asm volatile("" ::: "memory");
        }
        const PG8_LAS float* RS = (const PG8_LAS float*)(lds + 131072);
        const int col = u.pn * 128 + cl;
#pragma unroll
        for (int ai = 0; ai < 2; ++ai)
#pragma unroll
            for (int m = 0; m < 4; ++m) {
                const int rl = ai * HALF + wr * 64 + m * 16 + fr, gidx = ai * 8 + wr * 4 + m;
                const float sc = RS[rl], sc1 = RS[rl >= 1 ? rl - 1 : 0], sc2 = RS[rl >= 2 ? rl - 2 : 0];
                u32x4 h1 = (u32x4){0u, 0u, 0u, 0u}, h0 = h1;
                if (fr < 2 && gidx > 0) { h1 = *(const PG8_LAS u32x4*)(HB + (((gidx - 1) * 2 + 1) * 128 + cl) * 2); h0 = *(const PG8_LAS u32x4*)(HB + (((gidx - 1) * 2 + 0) * 128 + cl) * 2); }
                float o[8];
#pragma unroll
                for (int hf = 0; hf < 2; ++hf) {
                    const f32x4 w0 = *(const f32x4*)(cw + col + 4 * hf), w1 = *(const f32x4*)(cw + DFF + col + 4 * hf), w2 = *(const f32x4*)(cw + 2 * DFF + col + 4 * hf);
                    float cur[4], p1[4], p2[4];
#pragma unroll
                    for (int k = 0; k < 4; ++k) { cur[k] = acc[ai][0][m][hf][k] * sc;
                        p1[k] = __int_as_float(__builtin_amdgcn_update_dpp(__float_as_int(cur[k]), __float_as_int(cur[k]), 0x111, 0xf, 0xf, false));
                        p2[k] = __int_as_float(__builtin_amdgcn_update_dpp(__float_as_int(cur[k]), __float_as_int(cur[k]), 0x112, 0xf, 0xf, false)); }
                    if (fr < 2) {
                        const float e0 = bf_lo(h1[2 * hf]), e1 = bf_hi(h1[2 * hf]), e2 = bf_lo(h1[2 * hf + 1]), e3 = bf_hi(h1[2 * hf + 1]);
                        if (fr == 0) {
                            p1[0] = e0 * sc1; p1[1] = e1 * sc1; p1[2] = e2 * sc1; p1[3] = e3 * sc1;
                            p2[0] = bf_lo(h0[2 * hf]) * sc2; p2[1] = bf_hi(h0[2 * hf]) * sc2; p2[2] = bf_lo(h0[2 * hf + 1]) * sc2; p2[3] = bf_hi(h0[2 * hf + 1]) * sc2;
                        } else { p2[0] = e0 * sc2; p2[1] = e1 * sc2; p2[2] = e2 * sc2; p2[3] = e3 * sc2; }
                    }
#pragma unroll
                    for (int k = 0; k < 4; ++k) {
                        const float gc = w0[k] * p2[k] + w1[k] * p1[k] + w2[k] * cur[k];
                        const float upv = acc[ai][1][m][hf][k] * sc;
                        o[4 * hf + k] = gc * __builtin_amdgcn_rcpf(1.0f + __builtin_amdgcn_exp2f(-gc * LOG2E)) * upv;
                    }
                }
                const int row = rb + rl;
                if ((u.pm == 0 ? rl < 254 : rl >= 2) && row < MT) {
                    u32x4 w; w.x = cvt_pk_bf16(o[0], o[1]); w.y = cvt_pk_bf16(o[2], o[3]); w.z = cvt_pk_bf16(o[4], o[5]); w.w = cvt_pk_bf16(o[6], o[7]);
                    *(u32x4*)(act + (size_t)row * DFF + col) = w;
                }
            }
    }
};

template <class Final> struct EpiSplitK {
    static constexpr bool PERM = Final::PERM, AFTER_DRAIN = true, OVERLAP = false;
    Final fin; float* partials; unsigned* cnt;
    __device__ __forceinline__ void fused(f32x4 (&acc)[2][2][4][2], const Unit& u, int wr, int wc, int fr, int fq, PG8_LAS unsigned char* lds, int tid) const {
        const int slot = (int)blockIdx.x >> 2;
        f32x4* mine = (f32x4*)(partials + ((size_t)slot * 4 + u.ks) * 65536) + tid;
#pragma unroll
        for (int ai = 0; ai < 2; ++ai)
#pragma unroll
            for (int bj = 0; bj < 2; ++bj)
#pragma unroll
                for (int m = 0; m < 4; ++m)
#pragma unroll
                    for (int n = 0; n < 2; ++n) mine[(size_t)(((ai * 2 + bj) * 4 + m) * 2 + n) * 512] = acc[ai][bj][m][n];
        asm volatile("s_waitcnt vmcnt(0)" ::: "memory");
        __builtin_amdgcn_s_barrier();
        if (tid == 0) {
            __builtin_amdgcn_fence(__ATOMIC_RELEASE, "agent");
            asm volatile("s_waitcnt vmcnt(0)" ::: "memory");
            (void)__hip_atomic_fetch_add(cnt + slot, 1u, __ATOMIC_RELAXED, __HIP_MEMORY_SCOPE_AGENT);
            unsigned sp = 0;
            while (__hip_atomic_load(cnt + slot, __ATOMIC_RELAXED, __HIP_MEMORY_SCOPE_AGENT) < 4u) { __builtin_amdgcn_s_sleep(1); if (++sp > (1u << 22)) break; }
            __builtin_amdgcn_fence(__ATOMIC_ACQUIRE, "agent");
            asm volatile("s_waitcnt vmcnt(0)" ::: "memory");
        }
        asm volatile("" ::: "memory"); __builtin_amdgcn_s_barrier(); asm volatile("" ::: "memory");
        const int qa = u.ks >> 1, qm = (u.ks & 1) * 2;
        const f32x4* base = (const f32x4*)(partials + (size_t)slot * 4 * 65536) + tid;
#pragma unroll
        for (int bj = 0; bj < 2; ++bj) {
            f32x4 pp[2][2][4];
#pragma unroll
            for (int mm = 0; mm < 2; ++mm)
#pragma unroll
                for (int n = 0; n < 2; ++n)
#pragma unroll
                    for (int sl = 0; sl < 4; ++sl) pp[mm][n][sl] = base[(size_t)sl * 16384 + (size_t)(((qa * 2 + bj) * 4 + qm + mm) * 2 + n) * 512];
#pragma unroll
            for (int ai = 0; ai < 2; ++ai)
#pragma unroll
                for (int mh = 0; mh < 2; ++mh)
                    if (ai == qa && mh * 2 == qm) {
#pragma unroll
                        for (int mm = 0; mm < 2; ++mm)
#pragma unroll
                            for (int n = 0; n < 2; ++n) acc[ai][bj][mh * 2 + mm][n] = ((pp[mm][n][0] + pp[mm][n][1]) + pp[mm][n][2]) + pp[mm][n][3];
                    }
            asm volatile("" ::: "memory");
        }
        fin(acc, u, wr, wc, fr, fq, lds, tid, (int)u.ks);
    }
};

template <class Epi, class Sched, bool ALIGN_EPI = false, bool SP2 = false>
__device__ __forceinline__ void gemm_phase(PG8_LAS unsigned char* lds, const Gemm g, const Sched& S, const Epi& E) {
    int tid = threadIdx.x; asm volatile("" : "+v"(tid));
    const int wid = __builtin_amdgcn_readfirstlane(tid >> 6), lane = tid & 63, wr = wid >> 2, wc = wid & 3, fr = lane & 15, fq = lane >> 4;
    const int K = g.K, nt = K / BK;
    unsigned voffA[2], voffB[2];
#pragma unroll
    for (int i = 0; i < 2; ++i) { int R, C; stage_rc(tid * 16 + i * 8192, R, C); const int Rb = Epi::PERM ? ((R & ~31) + perm32(R & 31)) : R;
        voffA[i] = (unsigned)(R * g.ld + C) * 2u; voffB[i] = (unsigned)(Rb * g.ld + C) * 2u; }
    const size_t kstep = (size_t)(BK * 2);
    const size_t hstep = (size_t)HALF * g.ld * 2;
    const size_t tstep = 2 * hstep;
    const unsigned ldsw = (unsigned)wid * 1024u;
    const int aoff = lds_byte(wr * 64 + fr, fq * 8), boff = lds_byte(wc * 32 + fr, fq * 8);
#define PG8_SA(b, h) (((b) * 2 + (h)) * HTB)
#define PG8_SB(b, h) ((4 + (b) * 2 + (h)) * HTB)
#define PG8_STAGE(bufoff, gbase, voff) do { _Pragma("unroll") for (int _i = 0; _i < 2; ++_i) \
        __builtin_amdgcn_global_load_lds((const unsigned*)((const char*)(gbase) + (voff)[_i]), (PG8_LAS unsigned*)(lds + (bufoff) + ldsw + _i * 8192), 16, 0, 0); } while (0)
#define PG8_LDA(dst, b, h) do { _Pragma("unroll") for (int m = 0; m < 4; ++m) _Pragma("unroll") for (int k = 0; k < 2; ++k) dst[m][k] = *(const PG8_LAS bf16x8*)(lds + PG8_SA(b, h) + aoff + m * 2048 + k * 1024); } while (0)
#define PG8_LDB(dst, b, h) do { _Pragma("unroll") for (int n = 0; n < 2; ++n) _Pragma("unroll") for (int k = 0; k < 2; ++k) dst[n][k] = *(const PG8_LAS bf16x8*)(lds + PG8_SB(b, h) + boff + n * 2048 + k * 1024); } while (0)
#define PG8_MMA(ai, bj, At, Bt) do { __builtin_amdgcn_s_setprio(1); _Pragma("unroll") for (int m = 0; m < 4; ++m) _Pragma("unroll") for (int n = 0; n < 2; ++n) _Pragma("unroll") for (int k = 0; k < 2; ++k) \
        acc[ai][bj][m][n] = __builtin_amdgcn_mfma_f32_16x16x32_bf16(Bt[n][k], At[m][k], acc[ai][bj][m][n], 0, 0, 0); __builtin_amdgcn_s_setprio(0); } while (0)
#define PG8_WAIT_V(n) asm volatile("s_waitcnt vmcnt(" #n ")" ::: "memory")
#define PG8_WAIT_L(n) asm volatile("s_waitcnt lgkmcnt(" #n ")" ::: "memory")
#define PG8_BAR __builtin_amdgcn_s_barrier()
#define PG8_SCHED __builtin_amdgcn_sched_barrier(0)
    Unit cur, nxt; int ui = 0;
    if (!S.next(0, cur)) return;
    f32x4 acc[2][2][4][2];
#pragma unroll
    for (int a = 0; a < 2; ++a)
#pragma unroll
        for (int b = 0; b < 2; ++b)
#pragma unroll
            for (int m = 0; m < 4; ++m)
#pragma unroll
                for (int n = 0; n < 2; ++n) acc[a][b][m][n] = (f32x4){0.f, 0.f, 0.f, 0.f};
    bf16x8 At[4][2], B0[2][2], B1[2][2];
#define PG8_AROW(pm_) (Epi::OVERLAP ? (size_t)((pm_) * 254 - 2 > 0 ? (pm_) * 254 - 2 : 0) * ((size_t)g.ld * 2) : (size_t)(pm_) * tstep)
    const char* cA = (const char*)g.A + PG8_AROW(cur.pm) + (size_t)cur.ks * K * 2; const char* cB = (const char*)g.Bt + (size_t)cur.pn * tstep + (size_t)cur.ks * K * 2;
    S.a_ready(cur);
    if constexpr (SP2) {
        PG8_STAGE(PG8_SB(0, 0), cB, voffB); PG8_STAGE(PG8_SB(0, 1), cB + hstep, voffB); PG8_STAGE(PG8_SA(0, 0), cA, voffA); PG8_STAGE(PG8_SA(0, 1), cA + hstep, voffA);
        if (wr == 1) PG8_BAR;
        PG8_WAIT_V(2); PG8_BAR;
        PG8_STAGE(PG8_SB(1, 0), cB + kstep, voffB); PG8_STAGE(PG8_SA(1, 0), cA + kstep, voffA); PG8_STAGE(PG8_SB(1, 1), cB + hstep + kstep, voffB);
        PG8_WAIT_V(6); PG8_BAR;
    } else {
        PG8_STAGE(PG8_SB(0, 0), cB, voffB); PG8_STAGE(PG8_SA(0, 0), cA, voffA); PG8_STAGE(PG8_SB(0, 1), cB + hstep, voffB); PG8_STAGE(PG8_SA(0, 1), cA + hstep, voffA);
        if (wr == 1) PG8_BAR;
        PG8_WAIT_V(4); PG8_BAR;
        PG8_STAGE(PG8_SB(1, 0), cB + kstep, voffB); PG8_STAGE(PG8_SA(1, 0), cA + kstep, voffA); PG8_STAGE(PG8_SB(1, 1), cB + hstep + kstep, voffB);
        PG8_WAIT_V(6); PG8_BAR;
    }
    for (;;) {
        const bool has_next = S.next(ui + 1, nxt);
        const char* nA = has_next ? (const char*)g.A + PG8_AROW(nxt.pm) + (size_t)nxt.ks * K * 2 : cA; const char* nB = has_next ? (const char*)g.Bt + (size_t)nxt.pn * tstep + (size_t)nxt.ks * K * 2 : cB;
        for (int t = 0; t < nt; t += 2) {
            const bool last = (t == nt - 2);
            const char* a1 = cA + (size_t)(t + 1) * kstep;
            const char* a2 = last ? nA : cA + (size_t)(t + 2) * kstep; const char* b2 = last ? nB : cB + (size_t)(t + 2) * kstep;
            const char* a3 = a2 + kstep; const char* b3 = b2 + kstep;
            if (last && has_next) S.a_ready(nxt);
            if constexpr (SP2) {
            PG8_LDB(B0, 0, 0); PG8_LDB(B1, 0, 1); PG8_SCHED; PG8_LDA(At, 0, 0); PG8_STAGE(PG8_SA(1, 1), a1 + hstep, voffA);
            PG8_WAIT_V(8); PG8_WAIT_L(0); PG8_BAR; PG8_MMA(0, 0, At, B0); PG8_MMA(0, 1, At, B1); PG8_BAR; PG8_SCHED;
            PG8_LDA(At, 0, 1); PG8_STAGE(PG8_SB(0, 0), b2, voffB); PG8_STAGE(PG8_SB(0, 1), b2 + hstep, voffB); PG8_STAGE(PG8_SA(0, 0), a2, voffA);
            PG8_WAIT_V(8); PG8_WAIT_L(0); PG8_BAR; PG8_MMA(1, 0, At, B0); PG8_MMA(1, 1, At, B1); PG8_BAR; PG8_SCHED;
            PG8_LDB(B0, 1, 0); PG8_LDB(B1, 1, 1); PG8_SCHED; PG8_LDA(At, 1, 0); PG8_STAGE(PG8_SA(0, 1), a2 + hstep, voffA);
            PG8_WAIT_V(8); PG8_WAIT_L(0); PG8_BAR; PG8_MMA(0, 0, At, B0); PG8_MMA(0, 1, At, B1); PG8_BAR; PG8_SCHED;
            PG8_LDA(At, 1, 1); PG8_STAGE(PG8_SB(1, 0), b3, voffB); PG8_STAGE(PG8_SB(1, 1), b3 + hstep, voffB); PG8_STAGE(PG8_SA(1, 0), a3, voffA);
            PG8_WAIT_V(8); PG8_WAIT_L(0); PG8_BAR; PG8_MMA(1, 0, At, B0); PG8_MMA(1, 1, At, B1); PG8_BAR; PG8_SCHED;
            } else {
            PG8_LDB(B0, 0, 0); PG8_SCHED; PG8_LDA(At, 0, 0); PG8_STAGE(PG8_SA(1, 1), a1 + hstep, voffA);
            PG8_WAIT_L(8); PG8_BAR; PG8_WAIT_L(0); PG8_MMA(0, 0, At, B0); PG8_BAR; PG8_SCHED;
            PG8_LDB(B1, 0, 1); PG8_STAGE(PG8_SB(0, 0), b2, voffB);
            PG8_BAR; PG8_WAIT_L(0); PG8_MMA(0, 1, At, B1); PG8_BAR;
            PG8_LDA(At, 0, 1); PG8_STAGE(PG8_SA(0, 0), a2, voffA);
            PG8_BAR; PG8_WAIT_L(0); PG8_MMA(1, 0, At, B0); PG8_BAR; PG8_SCHED;
            PG8_STAGE(PG8_SB(0, 1), b2 + hstep, voffB);
            PG8_WAIT_V(6); PG8_BAR; PG8_MMA(1, 1, At, B1); PG8_BAR;
            PG8_LDB(B0, 1, 0); PG8_SCHED; PG8_LDA(At, 1, 0); PG8_STAGE(PG8_SA(0, 1), a2 + hstep, voffA);
            PG8_WAIT_L(8); PG8_BAR; PG8_WAIT_L(0); PG8_MMA(0, 0, At, B0); PG8_BAR; PG8_SCHED;
            PG8_LDB(B1, 1, 1); PG8_STAGE(PG8_SB(1, 0), b3, voffB);
            PG8_BAR; PG8_WAIT_L(0); PG8_MMA(0, 1, At, B1); PG8_BAR;
            PG8_LDA(At, 1, 1); PG8_STAGE(PG8_SA(1, 0), a3, voffA);
            PG8_BAR; PG8_WAIT_L(0); PG8_MMA(1, 0, At, B0); PG8_BAR; PG8_SCHED;
            PG8_STAGE(PG8_SB(1, 1), b3 + hstep, voffB);
            PG8_WAIT_V(6); PG8_BAR; PG8_MMA(1, 1, At, B1); PG8_BAR;
            }
        }
        if constexpr (ALIGN_EPI) { if (wr == 0) PG8_BAR; }
        if constexpr (!Epi::AFTER_DRAIN) { E(acc, cur, wr, wc, fr, fq, lds, tid); S.done(cur); }
        if (!has_next) break;
#pragma unroll
        for (int a = 0; a < 2; ++a)
#pragma unroll
            for (int b = 0; b < 2; ++b)
#pragma unroll
                for (int m = 0; m < 4; ++m)
#pragma unroll
                    for (int n = 0; n < 2; ++n) acc[a][b][m][n] = (f32x4){0.f, 0.f, 0.f, 0.f};
        cur = nxt; cA = nA; cB = nB; ++ui;
        if constexpr (ALIGN_EPI) { if (wr == 1) PG8_BAR; }
    }
    PG8_WAIT_V(0);
    if constexpr (!ALIGN_EPI) { if (wr == 0) PG8_BAR; }
    PG8_BAR;
    if constexpr (Epi::AFTER_DRAIN) { E.fused(acc, cur, wr, wc, fr, fq, lds, tid); S.done(cur); }
#undef PG8_AROW
#undef PG8_SA
#undef PG8_SB
#undef PG8_STAGE
#undef PG8_LDA
#undef PG8_LDB
#undef PG8_MMA
#undef PG8_WAIT_V
#undef PG8_WAIT_L
#undef PG8_BAR
#undef PG8_SCHED
}
}

#define MFMA32(a, b, c) __builtin_amdgcn_mfma_f32_32x32x16_bf16((a), (b), (c), 0, 0, 0)
__device__ __forceinline__ int crow(int reg, int h) { return (reg & 3) + 8 * (reg >> 2) + 4 * h; }
__device__ __forceinline__ s16x4 tr_read(const LAS unsigned char* p) { return __builtin_bit_cast(s16x4, __builtin_amdgcn_ds_read_tr16_b64_v4i16((LAS s16x4*)p)); }
__device__ __forceinline__ bf16x8 cat8(s16x4 lo, s16x4 hi) { return __builtin_shufflevector(lo, hi, 0, 1, 2, 3, 4, 5, 6, 7); }
__device__ __forceinline__ bf16x8 pack_step(const f32x16& x, int s) {
    u32x4 p;
    p.x = cvt_pk_bf16(x[8 * s + 0], x[8 * s + 1]); p.y = cvt_pk_bf16(x[8 * s + 2], x[8 * s + 3]);
    p.z = cvt_pk_bf16(x[8 * s + 4], x[8 * s + 5]); p.w = cvt_pk_bf16(x[8 * s + 6], x[8 * s + 7]);
    return __builtin_bit_cast(bf16x8, p);
}
__device__ __forceinline__ f32x16 zero16() { f32x16 z;
#pragma unroll
    for (int i = 0; i < 16; ++i) z[i] = 0.f; return z; }

namespace att {
constexpr int KSTR = 272, VSTR = 320;
constexpr int KSLOTB = 64 * KSTR, VSLOTB = 64 * VSTR;
constexpr int L_VRING = 2 * KSLOTB;
constexpr int L_X = 2 * KSLOTB + 2 * VSLOTB, XREG = 16896;
constexpr float THR = 6.0f;
#define ATT_BAR() asm volatile("s_waitcnt lgkmcnt(0)\n\ts_barrier" ::: "memory")
__device__ __forceinline__ unsigned scale_pk(unsigned w, float c) { return cvt_pk_bf16(bf_lo(w) * c, bf_hi(w) * c); }
__device__ __forceinline__ void kmax_unit(const bf16_t* __restrict__ proj, unsigned* __restrict__ kmax2, int u) {
    int tid = threadIdx.x; asm volatile("" : "+v"(tid));
    const int combo = u >> 2, quarter = u & 3, b = combo >> 4, h = (combo >> 1) & 7, map = combo & 1;
    float best = 0.f;
    for (int t = quarter * 1056 + tid; t < (quarter + 1) * 1056; t += 512) {
        const u32x4* p = (const u32x4*)(proj + ((size_t)b * LTOK + t) * DIN + C_AK + h * 128 + map * 64);
        float ss = 0.f;
#pragma unroll
        for (int c = 0; c < 8; ++c) { const u32x4 w = p[c];
#pragma unroll
            for (int k = 0; k < 4; ++k) { const float lo = bf_lo(w[k]), hi = bf_hi(w[k]); ss += lo * lo + hi * hi; } }
        best = fmaxf(best, ss);
    }
#pragma unroll
    for (int o = 1; o < 64; o <<= 1) best = fmaxf(best, __shfl_xor(best, o));
    if ((tid & 63) == 0) atomicMax(kmax2 + combo, __float_as_uint(best));
}
__device__ __forceinline__ void attn_unit(LAS unsigned char* lds, const bf16_t* __restrict__ proj, bf16_t* __restrict__ y, int b, int h, int qb,
                                          float lam, const float* __restrict__ subln, float post_scale, const unsigned* __restrict__ kmax2) {
    int tid = threadIdx.x; asm volatile("" : "+v"(tid));
    const int lane = tid & 63, wid = __builtin_amdgcn_readfirstlane(tid >> 6);
    const int map = wid & 1, g = wid >> 1, r = lane & 31, hh = lane >> 5;
    const int g16 = (lane >> 4) & 1, q4 = (lane & 15) >> 2, p4 = lane & 3;
    const size_t rowbase = (size_t)b * LTOK; const int q0 = qb * CH;
    const int qpos = q0 + g * 32 + r;
    const float slope = __builtin_amdgcn_exp2f(-(float)(h + 1));
    const float c1 = 0.125f * LOG2E, c2 = slope * LOG2E;
    bf16x8 qf[4];
    float qn2 = 0.f;
    { const bf16_t* qp = proj + (rowbase + qpos) * DIN + C_AQ + h * 128 + map * 64 + hh * 8;
#pragma unroll
      for (int s = 0; s < 4; ++s) { u32x4 w = *(const u32x4*)(qp + s * 16); w.x = scale_pk(w.x, c1); w.y = scale_pk(w.y, c1); w.z = scale_pk(w.z, c1); w.w = scale_pk(w.w, c1); qf[s] = __builtin_bit_cast(bf16x8, w);
#pragma unroll
          for (int k = 0; k < 4; ++k) { const float lo = bf_lo(w[k]), hi = bf_hi(w[k]); qn2 += lo * lo + hi * hi; } } }
    qn2 += __shfl_xor(qn2, 32);
    const float ub0 = sqrtf(qn2) * sqrtf(__uint_as_float(kmax2[(b * 8 + h) * 2 + map])) * 1.002f + 1.0f + c2 * (float)(63 - qpos) + 160.0f;
    LAS volatile unsigned char* FLG = (LAS volatile unsigned char*)(lds + LDS_MISC + 96);
    f32x16 o[4];
#pragma unroll
    for (int t = 0; t < 4; ++t) o[t] = zero16();
    float m_ref = 0.f, l_run = 0.f;
    const int jend = 2 * qb + 1;
    const int skey = tid >> 4, sc = tid & 15;
    const bf16_t* kg = proj + (rowbase + skey) * DIN + C_AK + h * 128 + sc * 8;
    const bf16_t* vg = proj + (rowbase + skey) * DIN + C_AV + h * 128 + sc * 8;
    u32x4 kreg[2], vreg[2];
#define LOADK(j) do { _Pragma("unroll") for (int i_ = 0; i_ < 2; ++i_) kreg[i_] = *(const u32x4*)(kg + (size_t)((j) * 64 + 32 * i_) * DIN); } while (0)
#define LOADV(j) do { _Pragma("unroll") for (int i_ = 0; i_ < 2; ++i_) vreg[i_] = *(const u32x4*)(vg + (size_t)((j) * 64 + 32 * i_) * DIN); } while (0)
#define STOREK(j) do { _Pragma("unroll") for (int i_ = 0; i_ < 2; ++i_) *(LAS u32x4*)(lds + ((j) & 1) * KSLOTB + (skey + 32 * i_) * KSTR + sc * 16) = kreg[i_]; } while (0)
#define STOREV(j) do { _Pragma("unroll") for (int i_ = 0; i_ < 2; ++i_) *(LAS u32x4*)(lds + L_VRING + ((j) & 1) * VSLOTB + (skey + 32 * i_) * VSTR + sc * 16) = vreg[i_]; } while (0)
    const int kAo = r * KSTR + map * 128 + hh * 16;
    const int vAo = L_VRING + (4 * hh + q4) * VSTR + 32 * g16 + 8 * p4;
    f32x16 s0, s1; float mx;
#define QK_TILE(jt) do { \
        const LAS unsigned char* kA0_ = lds + ((jt) & 1) * KSLOTB + kAo; bf16x8 kf_[4]; \
        _Pragma("unroll") for (int s_ = 0; s_ < 2; ++s_) { kf_[2 * s_] = *(const LAS bf16x8*)(kA0_ + s_ * 32); kf_[2 * s_ + 1] = *(const LAS bf16x8*)(kA0_ + 32 * KSTR + s_ * 32); } \
        const float base0_ = c2 * (float)((jt) * 64 + 4 * hh - qpos) - m_ref, base1_ = base0_ + 32.0f * c2; \
        _Pragma("unroll") for (int i_ = 0; i_ < 16; ++i_) { const float kq_ = (float)((i_ & 3) + 8 * (i_ >> 2)); s0[i_] = __builtin_fmaf(c2, kq_, base0_); s1[i_] = __builtin_fmaf(c2, kq_, base1_); } \
        __builtin_amdgcn_sched_barrier(0); \
        _Pragma("unroll") for (int s_ = 0; s_ < 2; ++s_) { s0 = MFMA32(kf_[2 * s_], qf[s_], s0); s1 = MFMA32(kf_[2 * s_ + 1], qf[s_], s1); } \
        _Pragma("unroll") for (int s_ = 0; s_ < 2; ++s_) { kf_[2 * s_] = *(const LAS bf16x8*)(kA0_ + (s_ + 2) * 32); kf_[2 * s_ + 1] = *(const LAS bf16x8*)(kA0_ + 32 * KSTR + (s_ + 2) * 32); } \
        __builtin_amdgcn_sched_barrier(0); \
        _Pragma("unroll") for (int s_ = 0; s_ < 2; ++s_) { s0 = MFMA32(kf_[2 * s_], qf[s_ + 2], s0); s1 = MFMA32(kf_[2 * s_ + 1], qf[s_ + 2], s1); } \
        __builtin_amdgcn_sched_barrier(0); \
        if ((jt) == 1 || (jt) >= 2 * qb) { const int kb_ = (jt) * 64 + 4 * hh; \
            _Pragma("unroll") for (int i_ = 0; i_ < 16; ++i_) { const int k0_ = kb_ + (i_ & 3) + 8 * (i_ >> 2), k1_ = k0_ + 32; \
                s0[i_] = (k0_ <= qpos && k0_ >= PADF) ? s0[i_] : -1e30f; s1[i_] = (k1_ <= qpos && k1_ >= PADF) ? s1[i_] : -1e30f; } } \
        mx = fmaxf(s0[0], s1[0]); \
        _Pragma("unroll") for (int i_ = 1; i_ < 16; ++i_) mx = fmaxf(fmaxf(mx, s0[i_]), s1[i_]); \
        mx = fmaxf(mx, __shfl_xor(mx, 32)); } while (0)
    bf16x8 pb[4];
    LOADK(jend); LOADV(jend);
    ATT_BAR();
    STOREK(jend); STOREV(jend);
    if (jend >= 2) LOADK(jend - 1);
    if (lane == 0) { FLG[wid] = 0; FLG[8 + wid] = 0; }
    ATT_BAR();
    QK_TILE(jend);
    m_ref = mx > -1e29f ? mx : 0.f;
    { float ls = 0.f;
#pragma unroll
      for (int i = 0; i < 16; ++i) { s0[i] = __builtin_amdgcn_exp2f(s0[i] - m_ref); s1[i] = __builtin_amdgcn_exp2f(s1[i] - m_ref); ls += s0[i] + s1[i]; }
      l_run = ls; }
    pb[0] = pack_step(s0, 0); pb[1] = pack_step(s0, 1); pb[2] = pack_step(s1, 0); pb[3] = pack_step(s1, 1);
    if (jend >= 2) { STOREK(jend - 1); LOADV(jend - 1); if (jend >= 3) LOADK(jend - 2); }
    ATT_BAR();
#define ATT_VLOADH(hs, buf) do { const LAS unsigned char* vp_ = vA + ((((hs) >> 1) >> 1) * 32 + 16 * (((hs) >> 1) & 1)) * VSTR + ((hs) & 1) * 128; \
        _Pragma("unroll") for (int t_ = 0; t_ < 2; ++t_) vah[buf][t_] = cat8(tr_read(vp_ + t_ * 64), tr_read(vp_ + 8 * VSTR + t_ * 64)); } while (0)
    int j = jend;
    for (;; --j) {
        bool more = j > 1;
        if (more && j != jend) {
            const unsigned v0 = *(LAS volatile unsigned*)(FLG + ((j + 1) & 1) * 8), v1 = *(LAS volatile unsigned*)(FLG + ((j + 1) & 1) * 8 + 4);
            more = !(v0 == 0x01010101u && v1 == 0x01010101u);
        }
        if (!more) break;
        const LAS unsigned char* vA = lds + (j & 1) * VSLOTB + vAo;
        bf16x8 vah[2][2];
        QK_TILE(j - 1);
        ATT_VLOADH(0, 0); ATT_VLOADH(1, 1);
        __builtin_amdgcn_sched_barrier(0);
        float ls = 0.f;
#pragma unroll
        for (int hs = 0; hs < 8; ++hs) {
#pragma unroll
            for (int t = 0; t < 2; ++t) o[2 * (hs & 1) + t] = MFMA32(vah[hs & 1][t], pb[hs >> 1], o[2 * (hs & 1) + t]);
            if (hs + 2 < 8) ATT_VLOADH(hs + 2, hs & 1);
#pragma unroll
            for (int i = 2 * hs; i < 2 * hs + 2; ++i) { s0[i] = __builtin_amdgcn_exp2f(s0[i]); s1[i] = __builtin_amdgcn_exp2f(s1[i]); ls += s0[i] + s1[i]; }
            __builtin_amdgcn_sched_barrier(0);
        }
        l_run += ls;
        if (__any(mx > THR)) {
            const float dl = fmaxf(mx, 0.f);
            m_ref += dl;
            const float alpha = __builtin_amdgcn_exp2f(-dl);
            l_run *= alpha;
#pragma unroll
            for (int i = 0; i < 16; ++i) { s0[i] *= alpha; s1[i] *= alpha; }
#pragma unroll
            for (int t = 0; t < 4; ++t)
#pragma unroll
                for (int i = 0; i < 16; ++i) o[t][i] *= alpha;
        }
        pb[0] = pack_step(s0, 0); pb[1] = pack_step(s0, 1); pb[2] = pack_step(s1, 0); pb[3] = pack_step(s1, 1);
        STOREV(j - 1);
        if (j - 1 > 1) { STOREK(j - 2); LOADV(j - 2); if (j - 2 > 1) LOADK(j - 3); }
        {
            const bool skip = __all(ub0 + c2 * 64.0f * (float)(j - 2) - m_ref < 0.f);
            if (lane == 0) FLG[(j & 1) * 8 + wid] = skip ? 1 : 0;
        }
        ATT_BAR();
    }
    {
        const LAS unsigned char* vA = lds + (j & 1) * VSLOTB + vAo;
        bf16x8 vah[2][2];
        ATT_VLOADH(0, 0); ATT_VLOADH(1, 1);
#pragma unroll
        for (int hs = 0; hs < 8; ++hs) {
#pragma unroll
            for (int t = 0; t < 2; ++t) o[2 * (hs & 1) + t] = MFMA32(vah[hs & 1][t], pb[hs >> 1], o[2 * (hs & 1) + t]);
            if (hs + 2 < 8) ATT_VLOADH(hs + 2, hs & 1);
            __builtin_amdgcn_sched_barrier(0);
        }
    }
#undef ATT_VLOADH
#undef LOADK
#undef LOADV
#undef STOREK
#undef STOREV
#undef QK_TILE
    const float l_tot = l_run + __shfl_xor(l_run, 32);
    const float inv = l_tot > 0.f ? 1.0f / l_tot : 0.f;
    LAS float* X = (LAS float*)(lds + L_X + g * XREG);
    if (map == 1) {
#pragma unroll
        for (int t = 0; t < 4; ++t)
#pragma unroll
            for (int i = 0; i < 16; ++i) X[(t * 16 + i) * 64 + lane] = o[t][i] * inv;
    }
    ATT_BAR();
    if (map == 0) {
        float ss = 0.f;
#pragma unroll
        for (int t = 0; t < 4; ++t)
#pragma unroll
            for (int i = 0; i < 16; ++i) { const float v = o[t][i] * inv - lam * X[(t * 16 + i) * 64 + lane]; o[t][i] = v; ss += v * v; }
        ss += __shfl_xor(ss, 32);
        const float rstd = __builtin_amdgcn_rsqf(ss * (1.0f / 128.0f) + EPS) * post_scale;
        asm volatile("s_waitcnt lgkmcnt(0)" ::: "memory");
#pragma unroll
        for (int t = 0; t < 4; ++t)
#pragma unroll
            for (int gq = 0; gq < 4; ++gq) {
                const f32x4 v = (f32x4){o[t][4 * gq] * rstd, o[t][4 * gq + 1] * rstd, o[t][4 * gq + 2] * rstd, o[t][4 * gq + 3] * rstd};
                *(LAS f32x4*)(X + r * 132 + t * 32 + 8 * gq + 4 * hh) = v;
            }
        asm volatile("s_waitcnt lgkmcnt(0)" ::: "memory");
        const int ch = lane & 15;
        const f32x4 w0 = *(const f32x4*)(subln + ch * 8), w1 = *(const f32x4*)(subln + ch * 8 + 4);
#pragma unroll
        for (int p = 0; p < 8; ++p) {
            const int row = p * 4 + (lane >> 4);
            const f32x4 v0 = *(const LAS f32x4*)(X + row * 132 + ch * 8) * w0, v1 = *(const LAS f32x4*)(X + row * 132 + ch * 8 + 4) * w1;
            u32x4 w; w.x = cvt_pk_bf16(v0[0], v0[1]); w.y = cvt_pk_bf16(v0[2], v0[3]); w.z = cvt_pk_bf16(v1[0], v1[1]); w.w = cvt_pk_bf16(v1[2], v1[3]);
            *(u32x4*)(y + (rowbase + q0 + g * 32 + row) * DM + h * 128 + ch * 8) = w;
        }
    }
    ATT_BAR();
}
}

namespace ret {
constexpr int KSTR = 320, VSTR = 576;
constexpr int L_K = 0, L_V = 128 * KSTR;
constexpr int M_V = 0, M_T = 0, TSTR = 260, M_SS = 128 * TSTR * 4;
__device__ __forceinline__ float log2gamma(int h) { return __builtin_log2f(1.0f - __builtin_amdgcn_exp2f(-(float)(5 + h))); }

__device__ __forceinline__ void kv_unit(LAS unsigned char* lds, const bf16_t* __restrict__ proj, bf16_t* __restrict__ kvT, int b, int h, int n) {
    int tid = threadIdx.x; asm volatile("" : "+v"(tid));
    const int lane = tid & 63, wid = __builtin_amdgcn_readfirstlane(tid >> 6);
    const int r = lane & 31, hh = lane >> 5, g16 = (lane >> 4) & 1, q4 = (lane & 15) >> 2, p4 = lane & 3;
    const size_t row0 = (size_t)b * LTOK + (size_t)n * CH;
    const float l2g = log2gamma(h);
    __syncthreads();
#pragma unroll
    for (int i = 0; i < 4; ++i) {
        const int j = (tid >> 4) + 32 * i, c = tid & 15;
        const u32x4 kk = *(const u32x4*)(proj + (row0 + j) * DIN + C_RK + h * 128 + c * 8);
        const float dec = __builtin_amdgcn_exp2f(l2g * (float)(127 - j)) * 0.08838834764831845f;
        u32x4 w;
#pragma unroll
        for (int k = 0; k < 4; ++k) w[k] = cvt_pk_bf16(bf_lo(kk[k]) * dec, bf_hi(kk[k]) * dec);
        *(LAS u32x4*)(lds + L_K + j * KSTR + c * 16) = w;
    }
#pragma unroll
    for (int i = 0; i < 8; ++i) {
        const int j = (tid >> 5) + 16 * i, c = tid & 31;
        const u32x4 vv = *(const u32x4*)(proj + (row0 + j) * DIN + C_RV + h * 256 + c * 8);
        *(LAS u32x4*)(lds + L_V + j * VSTR + c * 16) = vv;
    }
    __syncthreads();
    f32x16 acc[4];
#pragma unroll
    for (int t = 0; t < 4; ++t) acc[t] = zero16();
    const LAS unsigned char* va = lds + L_V + (8 * hh + q4) * VSTR + (32 * wid + 16 * g16) * 2 + 8 * p4;
    const LAS unsigned char* ka = lds + L_K + (8 * hh + q4) * KSTR + (16 * g16) * 2 + 8 * p4;
    bf16x8 fa[2], fb[2][4];
#define KV_FRAGS(s, buf) do { fa[buf] = cat8(tr_read(va + (16 * (s)) * VSTR), tr_read(va + (16 * (s) + 4) * VSTR)); \
        _Pragma("unroll") for (int t_ = 0; t_ < 4; ++t_) fb[buf][t_] = cat8(tr_read(ka + (16 * (s)) * KSTR + t_ * 64), tr_read(ka + (16 * (s) + 4) * KSTR + t_ * 64)); } while (0)
    KV_FRAGS(0, 0);
#pragma unroll
    for (int s = 0; s < 8; ++s) {
        if (s + 1 < 8) KV_FRAGS(s + 1, (s + 1) & 1);
        __builtin_amdgcn_sched_barrier(0);
#pragma unroll
        for (int t = 0; t < 4; ++t) acc[t] = MFMA32(fa[s & 1], fb[s & 1][t], acc[t]);
        __builtin_amdgcn_sched_barrier(0);
    }
#undef KV_FRAGS
    bf16_t* outp = kvT + ((size_t)((b * 4 + h) * NCH + n)) * 32768;
#pragma unroll
    for (int t = 0; t < 4; ++t)
#pragma unroll
        for (int i = 0; i < 16; ++i) outp[(size_t)(32 * wid + crow(i, hh)) * 128 + t * 32 + r] = (bf16_t)(cvt_pk_bf16(acc[t][i], 0.f) & 0xffffu);
}

__device__ __forceinline__ void scan_phase(const bf16_t* __restrict__ kvT, bf16_t* __restrict__ sprevT, int gtid, int gthreads) {
    for (int it = gtid; it < 16 * 8192; it += gthreads) {
        const int bh = it >> 13, e = (it & 8191) * 4;
        const float gam = __builtin_amdgcn_exp2f(log2gamma(bh & 3) * 128.0f);
        f32x4 run = (f32x4){0.f, 0.f, 0.f, 0.f};
        const bf16_t* kp = kvT + (size_t)bh * NCH * 32768 + e;
        bf16_t* sp = sprevT + (size_t)bh * NCH * 32768 + e;
#pragma unroll 1
        for (int n0 = 0; n0 < NCH - 1; n0 += 8) {
            f32x4 kvv[8];
#pragma unroll
            for (int k = 0; k < 8; ++k) { const u32x2 w_ = __builtin_nontemporal_load((const u32x2*)(kp + (size_t)(n0 + k) * 32768)); kvv[k] = (f32x4){bf_lo(w_.x), bf_hi(w_.x), bf_lo(w_.y), bf_hi(w_.y)}; }
#pragma unroll
            for (int k = 0; k < 8; ++k) {
                u32x2 w; w.x = cvt_pk_bf16(run[0], run[1]); w.y = cvt_pk_bf16(run[2], run[3]);
                *(u32x2*)(sp + (size_t)(n0 + k) * 32768) = w;
                run = run * gam + kvv[k];
            }
        }
        { u32x2 w; w.x = cvt_pk_bf16(run[0], run[1]); w.y = cvt_pk_bf16(run[2], run[3]); *(u32x2*)(sp + (size_t)(NCH - 1) * 32768) = w; }
    }
}

__device__ __forceinline__ void main_unit(LAS unsigned char* lds, const bf16_t* __restrict__ proj, const bf16_t* __restrict__ sprevT, bf16_t* __restrict__ y,
                                          const float* __restrict__ rnorm, int b, int h, int n) {
    int tid = threadIdx.x; asm volatile("" : "+v"(tid));
    const int lane = tid & 63, wid = __builtin_amdgcn_readfirstlane(tid >> 6);
    const int ig = wid & 3, dh = wid >> 2, r = lane & 31, hh = lane >> 5, g16 = (lane >> 4) & 1, q4 = (lane & 15) >> 2, p4 = lane & 3;
    const size_t row0 = (size_t)b * LTOK + (size_t)n * CH;
    const float l2g = log2gamma(h);
    const int iloc = ig * 32 + r;
    __syncthreads();
#pragma unroll
    for (int i = 0; i < 8; ++i) {
        const int j = (tid >> 5) + 16 * i, c = tid & 31;
        const u32x4 vv = *(const u32x4*)(proj + (row0 + j) * DIN + C_RV + h * 256 + c * 8);
        *(LAS u32x4*)(lds + M_V + j * VSTR + c * 16) = vv;
    }
    bf16x8 qf[8];
    { const bf16_t* qp = proj + (row0 + iloc) * DIN + C_RQ + h * 128 + hh * 8;
#pragma unroll
      for (int s = 0; s < 8; ++s) qf[s] = *(const bf16x8*)(qp + s * 16); }
    f32x16 acc[4];
#pragma unroll
    for (int t = 0; t < 4; ++t) acc[t] = zero16();
    { const bf16_t* sp = sprevT + ((size_t)((b * 4 + h) * NCH + n)) * 32768 + (size_t)(dh * 128 + r) * 128 + hh * 8;
      bf16x8 sa[8][4];
#pragma unroll
      for (int s = 0; s < 8; ++s)
#pragma unroll
          for (int t = 0; t < 4; ++t) sa[s][t] = *(const bf16x8*)(sp + (size_t)t * 32 * 128 + s * 16);
#pragma unroll
      for (int s = 0; s < 8; ++s)
#pragma unroll
          for (int t = 0; t < 4; ++t) acc[t] = MFMA32(sa[s][t], qf[s], acc[t]); }
    { const float qd = __builtin_amdgcn_exp2f(l2g * (float)(iloc + 1));
#pragma unroll
      for (int t = 0; t < 4; ++t)
#pragma unroll
          for (int i = 0; i < 16; ++i) acc[t][i] *= qd; }
    __syncthreads();
    const LAS unsigned char* va = lds + M_V + (4 * hh + q4) * VSTR + (dh * 128 + 16 * g16) * 2 + 8 * p4;
    for (int jt = 0; jt <= ig; ++jt) {
        f32x16 st = zero16();
        const bf16_t* kp = proj + (row0 + jt * 32 + r) * DIN + C_RK + h * 128 + hh * 8;
        bf16x8 ka[8];
#pragma unroll
        for (int s = 0; s < 8; ++s) ka[s] = *(const bf16x8*)(kp + s * 16);
#pragma unroll
        for (int s = 0; s < 8; ++s) st = MFMA32(ka[s], qf[s], st);
#pragma unroll
        for (int i = 0; i < 16; ++i) {
            const int d = iloc - (jt * 32 + crow(i, hh));
            const float f = __builtin_amdgcn_exp2f(l2g * (float)d) * 0.08838834764831845f;
            st[i] = d >= 0 ? st[i] * f : 0.f;
        }
#pragma unroll
        for (int s2 = 0; s2 < 2; ++s2) {
            const bf16x8 pb = pack_step(st, s2);
            const LAS unsigned char* vp = va + (jt * 32 + 16 * s2) * VSTR;
#pragma unroll
            for (int t = 0; t < 4; ++t) { const bf16x8 a = cat8(tr_read(vp + t * 64), tr_read(vp + 8 * VSTR + t * 64)); acc[t] = MFMA32(a, pb, acc[t]); }
        }
    }
    float ss = 0.f;
#pragma unroll
    for (int t = 0; t < 4; ++t)
#pragma unroll
        for (int i = 0; i < 16; ++i) ss += acc[t][i] * acc[t][i];
    ss += __shfl_xor(ss, 32);
    LAS float* SS = (LAS float*)(lds + M_SS);
    if (hh == 0) SS[dh * 128 + iloc] = ss;
    __syncthreads();
    const float rstd = __builtin_amdgcn_rsqf((SS[iloc] + SS[128 + iloc]) * (1.0f / 256.0f) + EPS);
    LAS float* T = (LAS float*)(lds + M_T);
#pragma unroll
    for (int t = 0; t < 4; ++t)
#pragma unroll
        for (int gq = 0; gq < 4; ++gq) {
            const f32x4 v = (f32x4){acc[t][4 * gq] * rstd, acc[t][4 * gq + 1] * rstd, acc[t][4 * gq + 2] * rstd, acc[t][4 * gq + 3] * rstd};
            *(LAS f32x4*)(T + iloc * TSTR + dh * 128 + t * 32 + 8 * gq + 4 * hh) = v;
        }
    __syncthreads();
    { const int c = tid & 31;
      const f32x4 w0 = *(const f32x4*)(rnorm + c * 8), w1 = *(const f32x4*)(rnorm + c * 8 + 4);
#pragma unroll
      for (int p = 0; p < 8; ++p) {
          const int row = (tid >> 5) + 16 * p;
          const f32x4 v0 = *(const LAS f32x4*)(T + row * TSTR + c * 8) * w0, v1 = *(const LAS f32x4*)(T + row * TSTR + c * 8 + 4) * w1;
          const u32x4 gg = *(const u32x4*)(proj + (row0 + row) * DIN + C_RG + h * 256 + c * 8);
          float o[8];
#pragma unroll
          for (int k = 0; k < 4; ++k) {
              const float gl = bf_lo(gg[k]), gh = bf_hi(gg[k]);
              const float vl = k < 2 ? v0[2 * k] : v1[2 * k - 4], vh = k < 2 ? v0[2 * k + 1] : v1[2 * k - 3];
              o[2 * k] = vl * gl * __builtin_amdgcn_rcpf(1.0f + __builtin_amdgcn_exp2f(-gl * LOG2E));
              o[2 * k + 1] = vh * gh * __builtin_amdgcn_rcpf(1.0f + __builtin_amdgcn_exp2f(-gh * LOG2E));
          }
          u32x4 w; w.x = cvt_pk_bf16(o[0], o[1]); w.y = cvt_pk_bf16(o[2], o[3]); w.z = cvt_pk_bf16(o[4], o[5]); w.w = cvt_pk_bf16(o[6], o[7]);
          *(u32x4*)(y + (row0 + row) * DM + 1024 + h * 256 + c * 8) = w;
      } }
    __syncthreads();
}
}

__device__ __forceinline__ void transpose_item(const float* __restrict__ W, int K, int N, bf16_t* __restrict__ WT, const float* __restrict__ gain, LAS float* scr, int item, int lane, int mode = 0) {
    const int nblk = N / 32, kb = item / nblk, nb = item % nblk, k0 = 64 * kb, n0 = 32 * nb;
#pragma unroll 8
    for (int i = 0; i < 32; ++i) { const int kk = 2 * i + (lane >> 5); float v = __builtin_nontemporal_load(W + (size_t)(k0 + kk) * N + n0 + (lane & 31)); if (gain) v *= gain[k0 + kk]; scr[kk * 33 + (lane & 31)] = v; }
    asm volatile("s_waitcnt lgkmcnt(0)" ::: "memory");
    const int c = lane & 7;
#pragma unroll
    for (int j = 0; j < 4; ++j) { const int n = (lane >> 3) + 8 * j; const LAS float* s = scr + (8 * c) * 33 + n;
        u32x4 o; o.x = cvt_pk_bf16(s[0 * 33], s[1 * 33]); o.y = cvt_pk_bf16(s[2 * 33], s[3 * 33]); o.z = cvt_pk_bf16(s[4 * 33], s[5 * 33]); o.w = cvt_pk_bf16(s[6 * 33], s[7 * 33]);
        const int nn = n0 + n; const int orow = mode ? ((nn >> 7) * 256 + (nn & 127) + (mode == 2 ? 128 : 0)) : nn;
        *(u32x4*)(WT + (size_t)orow * K + k0 + 8 * c) = o; }
    asm volatile("s_waitcnt lgkmcnt(0)" ::: "memory");
}


struct Args;
__device__ __forceinline__ void convert_layer(const Args& a, unsigned char* ws, LAS unsigned char* lds, int l, int worker, int nworkers, int wave, int lane, int it_lo, int it_hi);
#define XB_TMO      128
#define XB_XCNT(j)  (256  + 64 * (j))
#define XB_XSUB(j)  (1280 + 64 * (j))
#define XB_XGEN(j)  (2304 + 64 * (j))
#define XB_TOP      3328
#define XB_TOPGEN   3392
#define XCD_BAR_WORDS 3456
#define XB_SPIN_CAP (1u << 20)
__device__ __forceinline__ unsigned xb_ld(unsigned* p)              { return __hip_atomic_load(p, __ATOMIC_RELAXED, __HIP_MEMORY_SCOPE_AGENT); }
__device__ __forceinline__ unsigned xb_add(unsigned* p, unsigned v) { return __hip_atomic_fetch_add(p, v, __ATOMIC_RELAXED, __HIP_MEMORY_SCOPE_AGENT); }
__device__ __forceinline__ unsigned xb_xcc_id() { return (unsigned)__builtin_amdgcn_s_getreg((3 << 11) | 20) & 0xFu; }
#define XB_SPIN(cond, bar) do { unsigned _sp = 0; while (cond) { __builtin_amdgcn_s_sleep(1); \
    if ((++_sp & 255u) == 0u) { if (xb_ld(&(bar)[XB_TMO])) break; if (_sp > XB_SPIN_CAP) { atomicAdd(&(bar)[XB_TMO], 1u); break; } } } } while (0)
struct XcdBarrier { unsigned* bar; unsigned x; volatile LAS unsigned* st; };
__device__ __forceinline__ XcdBarrier xcd_barrier_post(unsigned* bar, volatile LAS unsigned* st) {
    XcdBarrier b; b.bar = bar; b.x = xb_xcc_id(); b.st = st;
    if (threadIdx.x == 0) (void)xb_add(&bar[XB_XCNT(b.x)], 1u);
    return b;
}
__device__ __forceinline__ void xcd_barrier_complete(unsigned* bar, unsigned x, unsigned& nloc, unsigned& nx) {
    const unsigned G = gridDim.x * gridDim.y * gridDim.z;
    unsigned sum, cnt, mine, sp = 0u;
    for (;;) {
        sum = 0u; cnt = 0u; mine = 0u;
#pragma unroll
        for (unsigned j = 0; j < 16; ++j) { const unsigned c = xb_ld(&bar[XB_XCNT(j)]); sum += c; cnt += (c > 0u) ? 1u : 0u; mine = (j == x) ? c : mine; }
        if (sum == G) break;
        __builtin_amdgcn_s_sleep(1);
        if ((++sp & 255u) == 0u) { if (xb_ld(&bar[XB_TMO])) break; if (sp > XB_SPIN_CAP) { atomicAdd(&bar[XB_TMO], 1u); break; } }
    }
    nloc = mine > 0u ? mine : 1u; nx = cnt > 0u ? cnt : 1u;
}
__device__ __forceinline__ void xcd_barrier(const XcdBarrier& b) {
    asm volatile("s_waitcnt vmcnt(0)" ::: "memory");
    __syncthreads();
    if (threadIdx.x == 0) {
        unsigned* bar = b.bar;
        __builtin_amdgcn_s_waitcnt(0);
        unsigned nloc = b.st[0], nx = b.st[1];
        if (nloc == 0u) { xcd_barrier_complete(bar, b.x, nloc, nx); b.st[0] = nloc; b.st[1] = nx; }
        const unsigned old = xb_add(&bar[XB_XSUB(b.x)], 1u);
        const unsigned gen = old / nloc;
        if (old + 1u == (gen + 1u) * nloc) {
            __builtin_amdgcn_fence(__ATOMIC_RELEASE, "agent");
            asm volatile("s_waitcnt vmcnt(0)" ::: "memory");
            const unsigned og = xb_add(&bar[XB_TOP], 1u);
            const unsigned tg = og / nx;
            if (og + 1u == (tg + 1u) * nx) xb_add(&bar[XB_TOPGEN], 1u);
            else XB_SPIN(xb_ld(&bar[XB_TOPGEN]) == tg, bar);
            __builtin_amdgcn_fence(__ATOMIC_ACQUIRE, "agent");
            xb_add(&bar[XB_XGEN(b.x)], 1u);
            asm volatile("s_waitcnt vmcnt(0)" ::: "memory");
        } else {
            XB_SPIN(xb_ld(&bar[XB_XGEN(b.x)]) == gen, bar);
            __builtin_amdgcn_fence(__ATOMIC_ACQUIRE, "agent");
            asm volatile("s_waitcnt vmcnt(0)" ::: "memory");
        }
    }
    __syncthreads();
}

struct Args {
    const float* x; const float* meta; const float* attn_norm; const float* w_in; const float* lambda_qk; const float* attn_subln; const float* ret_norm;
    const float* w_out; const float* ffn_norm; const float* w_gate; const float* w_up; const float* conv_w; const float* w_down; const float* final_norm;
    float* out; unsigned char* ws;
};


__device__ __forceinline__ void convert_layer(const Args& a, unsigned char* ws, LAS unsigned char* lds, int l, int worker, int nworkers, int wave, int lane, int it_lo, int it_hi) {
    LAS float* scr = (LAS float*)(lds + wave * 16384);
    constexpr int I_IN = 32 * 192, I_OUT = 32 * 64, I_G = 32 * 176, I_D = 88 * 64, I_LAYER = I_IN + I_OUT + 2 * I_G + I_D;
    unsigned char* wl = ws + WS_WT + (size_t)l * WT_LAYER;
    for (int it = it_lo + worker; it < it_hi; it += nworkers) {
        int rr = it;
        if (rr < I_IN) { transpose_item(a.w_in + (size_t)l * DM * DIN, DM, DIN, (bf16_t*)(wl + WT_IN), a.attn_norm + l * DM, scr, rr, lane); continue; } rr -= I_IN;
        if (rr < I_OUT) { transpose_item(a.w_out + (size_t)l * DM * DM, DM, DM, (bf16_t*)(wl + WT_OUT), nullptr, scr, rr, lane); continue; } rr -= I_OUT;
        if (rr < I_G) { transpose_item(a.w_gate + (size_t)l * DM * DFF, DM, DFF, (bf16_t*)(wl + WT_GATE), a.ffn_norm + l * DM, scr, rr, lane, 1); continue; } rr -= I_G;
        if (rr < I_G) { transpose_item(a.w_up + (size_t)l * DM * DFF, DM, DFF, (bf16_t*)(wl + WT_GATE), a.ffn_norm + l * DM, scr, rr, lane, 2); continue; } rr -= I_G;
        transpose_item(a.w_down + (size_t)l * DFF * DM, DFF, DM, (bf16_t*)(wl + WT_DOWN), nullptr, scr, rr, lane);
    }
}

__global__ void __launch_bounds__(512, 2) hymba_fwd(Args a) {
    extern __shared__ __attribute__((aligned(16))) unsigned char lds_raw[];
    LAS unsigned char* lds = (LAS unsigned char*)lds_raw;
    cg::grid_group grid = cg::this_grid();
#define FRESH_TID() int tid = threadIdx.x; asm volatile("" : "+v"(tid)); const int lane = tid & 63, wave = __builtin_amdgcn_readfirstlane(tid >> 6); (void)lane; (void)wave
    const int G = gridDim.x, bx = blockIdx.x;
    unsigned char* ws = a.ws;
    unsigned* ctl = (unsigned*)(ws + WS_CTL);
    float* ssqA = (float*)(ws + WS_SSQ);
    float* ssqF = ssqA + (size_t)MT * 32;
    bf16_t* hlo = (bf16_t*)(ws + WS_H);
    bf16_t* hb = (bf16_t*)(ws + WS_H + (size_t)MT * DM * 2);
    bf16_t* sprevT = (bf16_t*)((unsigned char*)a.out + OUT_SPREV);
    bf16_t* proj = (bf16_t*)(ws + WS_R + R_PROJ);
    bf16_t* ybuf = (bf16_t*)(ws + WS_R + R_Y);
    bf16_t* kvT = (bf16_t*)(ws + WS_R + R_KV);
    bf16_t* gbuf = (bf16_t*)(ws + WS_R + R_G);
    bf16_t* actbuf = (bf16_t*)(ws + WS_R + R_ACT);

    if (threadIdx.x < 64) ((LAS unsigned*)(lds + LDS_MISC))[threadIdx.x] = 0u;
    __syncthreads();
    if (threadIdx.x == 0) { ((LAS unsigned long long*)(lds + LDS_MISC + 64))[0] = (unsigned long long)a.x; ((LAS unsigned long long*)(lds + LDS_MISC + 64))[1] = (unsigned long long)a.meta; }
    for (int rep = 0; rep < REP_PRO; ++rep) {
        FRESH_TID();
        const int gtid = bx * 512 + tid, gth = G * 512;
        for (int i = gtid; i < 8192; i += gth) ctl[i] = 0u;
        const int gw = bx * 8 + wave, NGW = G * 8;
        for (int row = gw; row < MT; row += NGW) {
            const int bb = row / LTOK, t = row % LTOK;
            f32x4 v[8]; float s = 0.f;
            if (t < PADF) {
#pragma unroll
                for (int j = 0; j < 8; ++j) v[j] = (f32x4){0.f, 0.f, 0.f, 0.f};
            } else {
                const float* src = t < CH ? a.meta + (size_t)(t - PADF) * DM : a.x + ((size_t)bb * SEQ + (t - CH)) * DM;
#pragma unroll
                for (int j = 0; j < 8; ++j) { v[j] = __builtin_nontemporal_load((const f32x4*)src + 64 * j + lane); s += (v[j][0] * v[j][0] + v[j][1] * v[j][1]) + (v[j][2] * v[j][2] + v[j][3] * v[j][3]); }
            }
            s = wave_sum(s);
            if (lane < 32) ssqA[(size_t)row * 32 + lane] = lane == 0 ? s : 0.f;
#pragma unroll
            for (int j = 0; j < 8; ++j) {
                u32x2 w; w.x = cvt_pk_bf16(v[j][0], v[j][1]); w.y = cvt_pk_bf16(v[j][2], v[j][3]);
                *((u32x2*)(hb + (size_t)row * DM) + 64 * j + lane) = w;
            }
        }
        convert_layer(a, ws, lds, 0, gw, NGW, wave, lane, 0, CV_IN);
        convert_layer(a, ws, lds, 0, gw, NGW, wave, lane, CV_GATE, CV_ALL);
    }
    grid.sync();
    const XcdBarrier xbar = xcd_barrier_post(ctl + 4096, (volatile LAS unsigned*)(lds + LDS_MISC + 32));
#define GSYNC() xcd_barrier(xbar)

#pragma unroll 1
    for (int l = 0; l < DEPTH; ++l) {
        unsigned char* wl = ws + WS_WT + (size_t)l * WT_LAYER;
        for (int rep = 0; rep < REP_INP; ++rep) {
            pg8::Gemm g{hb, (const bf16_t*)(wl + WT_IN), MT, DIN, DM, DM}; pg8::StaticOrder S; S.init(MT, DIN, G, bx);
            pg8::EpiScaleBf16 E{proj, DIN, ssqA};
            pg8::gemm_phase<pg8::EpiScaleBf16, pg8::StaticOrder, true, true>(lds, g, S, E);
            if (l == 0 && bx >= 48) { FRESH_TID(); convert_layer(a, ws, lds, 0, (bx - 48) * 8 + wave, (G - 48) * 8, wave, lane, CV_IN, CV_GATE); }
        }
        GSYNC();
        for (int rep = 0; rep < REP_MIX; ++rep) {
        for (int rk = 0; rk < REP_KV; ++rk) {
        for (int u = bx; u < 16 * 32; u += G) ret::kv_unit(lds, proj, kvT, u >> 7, (u >> 5) & 3, u & 31);
        for (int u = bx; u < 256; u += G) att::kmax_unit(proj, ctl + 1536 + l * 64, u);
        GSYNC();
        { FRESH_TID(); ret::scan_phase(kvT, sprevT, bx * 512 + tid, G * 512); }
        GSYNC();
        }
        {
            FRESH_TID();
            float lam;
            { const float* lq = a.lambda_qk + l * 256;
              const float s1 = wave_sum(lq[lane] * lq[64 + lane]), s2 = wave_sum(lq[128 + lane] * lq[192 + lane]);
              const float lam_init = 0.8f - 0.6f * __expf(-0.3f * (float)l);
              lam = __expf(s1) - __expf(s2) + lam_init; }
            const float lam_init = 0.8f - 0.6f * __expf(-0.3f * (float)l);
            LAS volatile int* slot = (LAS volatile int*)(lds + LDS_MISC);
            for (int pass = 0; pass < 1 + XREP_ATT + XREP_RET; ++pass) {
                const int ulo = (pass > XREP_ATT) ? 1056 : 0, uhi = (pass >= 1 && pass <= XREP_ATT) ? 1056 : 1584;
                for (;;) {
                    if (tid == 0) *slot = ulo + (int)atomicAdd(ctl + 16 * l + 4 * rep + pass, 1u);
                    __syncthreads();
                    const int u = *slot;
                    if (u >= uhi) break;
                    if (u < 256 || u >= 256 + 528) { const int w = u < 256 ? u : u - 528; att::attn_unit(lds, proj, ybuf, w & 3, (w >> 2) & 7, 32 - (w >> 5), lam, a.attn_subln + l * 128, 1.0f - lam_init, ctl + 1536 + l * 64); }
                    else { const int v = u - 256; ret::main_unit(lds, proj, sprevT, ybuf, a.ret_norm + l * 256, v & 3, (v >> 2) & 3, v >> 4); }
                }
                __syncthreads();
            }
        }
        GSYNC();
        }
        {
            pg8::Gemm g{ybuf, (const bf16_t*)(wl + WT_OUT), MT, DM, DM, DM}; pg8::StaticOrder S; S.init(MT, DM, G, bx); S.limit = 2 * 256;
            pg8::Gemm gt{ybuf, (const bf16_t*)(wl + WT_OUT), MT, DM, 512, DM}; const pg8::TailOrder T{MT / 256, DM / 256, 2 * 256, 16, bx};
            float* const part = (float*)(ws + WS_R + R_PROJ);
            { pg8::EpiResidual<false> E{hlo, hb, ssqF, 1.f}; pg8::gemm_phase<pg8::EpiResidual<false>, pg8::StaticOrder, true, true>(lds, g, S, E);
                pg8::EpiSplitK<pg8::EpiResidual<false>> Et{E, part, ctl + 2048 + l * 256 + 64}; pg8::gemm_phase<pg8::EpiSplitK<pg8::EpiResidual<false>>, pg8::TailOrder, true, true>(lds, gt, T, Et); }
        }
        GSYNC();
        {
            pg8::Gemm g{hb, (const bf16_t*)(wl + WT_GATE), 67 * 256, 2 * DFF, DM, DM}; pg8::StaticOrder S; S.init(67 * 256, 2 * DFF, G, bx);
            pg8::EpiGateUp E{actbuf, a.conv_w + (size_t)l * 3 * DFF, ssqF};
            pg8::gemm_phase<pg8::EpiGateUp, pg8::StaticOrder, true, true>(lds, g, S, E);
        }
        GSYNC();
        for (int xs = 0; xs < XSYNC; ++xs) GSYNC();
        {
            pg8::Gemm g{actbuf, (const bf16_t*)(wl + WT_DOWN), MT, DM, DFF, DFF}; pg8::StaticOrder S; S.init(MT, DM, G, bx);
            pg8::EpiResidual<false> E{hlo, hb, ssqA, 1.f};
            if (l + 1 < DEPTH) {
                pg8::gemm_phase<pg8::EpiResidual<false>, pg8::StaticOrder, true, true>(lds, g, S, E);
                if (bx >= 16) { FRESH_TID(); convert_layer(a, ws, lds, l + 1, (bx - 16) * 8 + wave, (G - 16) * 8, wave, lane, 0, CV_ALL); }
            } else {
                S.limit = 2 * 256;
                pg8::gemm_phase<pg8::EpiResidual<false>, pg8::StaticOrder, true, true>(lds, g, S, E);
                pg8::Gemm gt{actbuf, (const bf16_t*)(wl + WT_DOWN), MT, DM, DFF / 4, DFF}; const pg8::TailOrder T{MT / 256, DM / 256, 2 * 256, 16, bx};
                pg8::EpiSplitK<pg8::EpiResidual<false>> Et{E, (float*)(ws + WS_R + R_G), ctl + 2048 + l * 256 + 128};
                pg8::gemm_phase<pg8::EpiSplitK<pg8::EpiResidual<false>>, pg8::TailOrder, true, true>(lds, gt, T, Et);
            }
        }
        GSYNC();
    }
    {
        FRESH_TID();
        const int gw = bx * 8 + wave, NGW = G * 8;
        f32x4 wv[8];
#pragma unroll
        for (int j = 0; j < 8; ++j) wv[j] = *((const f32x4*)a.final_norm + 64 * j + lane);
        for (int orow = gw; orow < NB * SEQ; orow += NGW) {
            const int bb = orow / SEQ, s = orow % SEQ; const int row = bb * LTOK + CH + s;
            const float rstd = row_rstd(ssqA, row);
#pragma unroll
            for (int j = 0; j < 8; ++j) {
                const u32x2 hi = *((const u32x2*)(hb + (size_t)row * DM) + 64 * j + lane);
                const f32x4 v = (f32x4){bf_lo(hi.x), bf_hi(hi.x), bf_lo(hi.y), bf_hi(hi.y)};
                *((f32x4*)(a.out + (size_t)orow * DM) + 64 * j + lane) = v * rstd * wv[j]; }
        }
    }
}

extern "C" void kernel_launch(void* const* d_in, const int* in_sizes, int n_in, void* d_out, int out_size, void* d_ws, size_t ws_size, hipStream_t stream) {
    static int grid = 0;
    if (grid == 0) {
        if (n_in != 14 || ws_size < WS_END || out_size != NB * SEQ * DM) { fprintf(stderr, "kernel_launch: unexpected problem shape (n_in %d, ws %zu need %zu, out %d)\n", n_in, ws_size, (size_t)WS_END, out_size); grid = -1; return; }
        int dev = 0, cus = 0, per_cu = 0;
        hipGetDevice(&dev);
        hipDeviceGetAttribute(&cus, hipDeviceAttributeMultiprocessorCount, dev);
        hipFuncSetAttribute((const void*)hymba_fwd, hipFuncAttributeMaxDynamicSharedMemorySize, LDS_BYTES);
        hipOccupancyMaxActiveBlocksPerMultiprocessor(&per_cu, (const void*)hymba_fwd, 512, LDS_BYTES);
        (void)hipGetLastError();
        if (per_cu < 1) per_cu = 1;
        grid = cus * 1;
    }
    if (grid < 0) return;
    Args a{};
    a.x = (const float*)d_in[0]; a.meta = (const float*)d_in[1]; a.attn_norm = (const float*)d_in[2]; a.w_in = (const float*)d_in[3];
    a.lambda_qk = (const float*)d_in[4]; a.attn_subln = (const float*)d_in[5]; a.ret_norm = (const float*)d_in[6]; a.w_out = (const float*)d_in[7];
    a.ffn_norm = (const float*)d_in[8]; a.w_gate = (const float*)d_in[9]; a.w_up = (const float*)d_in[10]; a.conv_w = (const float*)d_in[11];
    a.w_down = (const float*)d_in[12]; a.final_norm = (const float*)d_in[13];
    a.out = (float*)d_out; a.ws = (unsigned char*)d_ws;
    void* args[] = {&a};
    hipError_t e = hipLaunchCooperativeKernel((const void*)hymba_fwd, dim3(grid), dim3(512), args, LDS_BYTES, stream);
    if (e != hipSuccess) fprintf(stderr, "cooperative launch failed: %s (grid %d)\n", hipGetErrorString(e), grid);
}
```
